# Optimizing an MI355X kernel written in HIP

```python
import math
import jax, jax.numpy as jnp
from jax import lax
import numpy as np

D_MODEL = 1024
BATCH = 8
SEQ = 4096
DEPTH = 4

A_HEAD_DIM = 64
A_Q_HEADS = 8
A_KV_HEADS = 2
WINDOW = 128
ROPE_THETA = 10000.0
B_HEADS = 4
B_HEAD_DIM = 128
B_CONV = 4
B_CHUNK = 64
LRU_WIDTH = D_MODEL
LRU_BLOCKS = 4
LRU_CONV = 4
LRU_C = 8.0
D_FF = 4 * D_MODEL
A_Q_W = A_Q_HEADS * A_HEAD_DIM
A_KV_W = A_KV_HEADS * A_HEAD_DIM
B_W = B_HEADS * B_HEAD_DIM
HYB_SPLITS = (A_Q_W, A_KV_W, A_KV_W, 3 * B_W, B_W, B_HEADS, B_HEADS)
HYB_PROJ = A_Q_W + 2 * A_KV_W + 4 * B_W + 2 * B_HEADS
MIX_W = A_Q_W + B_W
N_HYB = (DEPTH + 1) // 2
N_REC = DEPTH // 2
DN_ALPHA = (2 * DEPTH) ** 0.25
DN_BETA = (8 * DEPTH) ** -0.25
LN_EPS = 1e-5
NORM_EPS = 1e-6

kernel_name = 'hybrid_swa_deltanet_rglru_deepnorm_trunk'


def split_cols(t, sizes):
    out, start = [], 0
    for s in sizes:
        out.append(t[..., start:start + s])
        start += s
    return out


def layer_norm(x, g, b):
    xf = x.astype(jnp.float32)
    mu = jnp.mean(xf, axis=-1, keepdims=True)
    var = jnp.mean(jnp.square(xf - mu), axis=-1, keepdims=True)
    y = (xf - mu) * lax.rsqrt(var + LN_EPS) * g.astype(jnp.float32) + b.astype(jnp.float32)
    return y.astype(x.dtype)


def l2_normalize(x):
    xf = x.astype(jnp.float32)
    return xf * lax.rsqrt(jnp.sum(xf * xf, axis=-1, keepdims=True) + NORM_EPS)


def apply_rope(x):
    T, dh = x.shape[1], x.shape[-1]
    half = dh // 2
    inv_freq = ROPE_THETA ** (-jnp.arange(half, dtype=jnp.float32) / half)
    ang = jnp.arange(T, dtype=jnp.float32)[:, None] * inv_freq[None, :]
    cos = jnp.cos(ang)[None, :, None, :]
    sin = jnp.sin(ang)[None, :, None, :]
    xf = x.astype(jnp.float32)
    x1, x2 = xf[..., :half], xf[..., half:]
    return jnp.concatenate([x1 * cos - x2 * sin, x2 * cos + x1 * sin], axis=-1).astype(x.dtype)


def causal_dwconv(x, w, b=None):
    K = w.shape[0]
    T = x.shape[1]
    xp = jnp.pad(x, ((0, 0), (K - 1, 0), (0, 0)))
    y = sum(xp[:, j:j + T] * w[j] for j in range(K))
    if b is not None:
        y = y + b
    return y


def sliding_window_attention(q, k, v, sinks):
    f32 = jnp.float32
    bsz, T, HQ, DH = q.shape
    HKV = k.shape[2]
    G = HQ // HKV
    W = WINDOW
    NB = T // W
    qb = q.reshape(bsz, NB, W, HKV, G, DH)

    def band(t):
        prev = jnp.pad(t, ((0, 0), (W, 0), (0, 0), (0, 0)))[:, :T]
        return jnp.concatenate([prev.reshape(bsz, NB, W, HKV, DH),
                                t.reshape(bsz, NB, W, HKV, DH)], axis=2)

    kb, vb = band(k), band(v)
    s = jnp.einsum('bnqhgd,bnkhd->bnhgqk', qb, kb).astype(f32) * (DH ** -0.5)
    dist = (jnp.arange(W)[:, None] + W) - jnp.arange(2 * W)[None, :]
    in_window = (dist >= 0) & (dist < W)
    key_pos = (jnp.arange(NB)[:, None] - 1) * W + jnp.arange(2 * W)[None, :]
    mask = in_window[None] & (key_pos >= 0)[:, None, :]
    s = jnp.where(mask[None, :, None, None], s, -jnp.inf)
    sink = jnp.broadcast_to(sinks.astype(f32).reshape(1, 1, HKV, G, 1, 1), s.shape[:-1] + (1,))
    p = jax.nn.softmax(jnp.concatenate([s, sink], axis=-1), axis=-1)[..., :-1]
    o = jnp.einsum('bnhgqk,bnkhd->bnqhgd', p.astype(v.dtype), vb)
    return o.reshape(bsz, T, HQ * DH)


def gated_delta_rule(q, k, v, g, beta):
    f32 = jnp.float32
    bsz, T, H, DK = q.shape
    DV = v.shape[-1]
    C = B_CHUNK
    N = T // C

    def chunk(t):
        t = t.astype(f32).reshape((bsz, N, C, H) + t.shape[3:])
        return jnp.moveaxis(t, 3, 1)

    q = chunk(q) * (DK ** -0.5)
    k = chunk(k)
    v = chunk(v)
    g = jnp.cumsum(chunk(g), axis=-1)
    beta = chunk(beta)
    k_beta = k * beta[..., None]
    v_beta = v * beta[..., None]
    idx = jnp.arange(C)
    incl = idx[:, None] >= idx[None, :]
    strict = idx[:, None] > idx[None, :]
    diff = g[..., :, None] - g[..., None, :]
    decay_incl = jnp.exp(jnp.where(incl, diff, -jnp.inf))
    decay_strict = jnp.where(strict, decay_incl, 0.0)
    a_mat = jnp.einsum('bhnik,bhnjk->bhnij', k_beta, k) * decay_strict
    eye = jnp.eye(C, dtype=f32)
    t_mat = lax.linalg.triangular_solve(a_mat + eye, jnp.broadcast_to(eye, a_mat.shape),
                                        left_side=True, lower=True, unit_diagonal=True)
    u = jnp.einsum('bhnij,bhnjv->bhniv', t_mat, v_beta)
    w = jnp.einsum('bhnij,bhnjk->bhnik', t_mat, k_beta * jnp.exp(g)[..., None])
    qk = jnp.einsum('bhnik,bhnjk->bhnij', q, k) * decay_incl
    q_g = q * jnp.exp(g)[..., None]
    g_last = g[..., -1]
    k_tail = k * jnp.exp(g_last[..., None] - g)[..., None]
    xs = tuple(jnp.moveaxis(t, 2, 0) for t in (q_g, k_tail, u, w, qk, g_last))

    def step(S, inp):
        q_c, kt_c, u_c, w_c, qk_c, gl_c = inp
        v_new = u_c - jnp.einsum('bhck,bhkv->bhcv', w_c, S)
        o_c = jnp.einsum('bhck,bhkv->bhcv', q_c, S) + jnp.einsum('bhij,bhjv->bhiv', qk_c, v_new)
        S = S * jnp.exp(gl_c)[..., None, None] + jnp.einsum('bhck,bhcv->bhkv', kt_c, v_new)
        return S, o_c

    S0 = jnp.zeros((bsz, H, DK, DV), f32)
    _, o = lax.scan(step, S0, xs)
    return jnp.transpose(o, (1, 0, 3, 2, 4)).reshape(bsz, T, H, DV)


def hybrid_mixer(x, w_in, sinks, conv_w, a_log, dt_bias, norm_w, w_out):
    f32 = jnp.float32
    bsz, T, _ = x.shape
    proj = x @ w_in
    qa, ka, va, qkv_b, z, beta_logit, a_logit = split_cols(proj, HYB_SPLITS)
    qa = apply_rope(qa.reshape(bsz, T, A_Q_HEADS, A_HEAD_DIM))
    ka = apply_rope(ka.reshape(bsz, T, A_KV_HEADS, A_HEAD_DIM))
    va = va.reshape(bsz, T, A_KV_HEADS, A_HEAD_DIM)
    o_a = sliding_window_attention(qa, ka, va, sinks)
    qkv_b = jax.nn.silu(causal_dwconv(qkv_b, conv_w))
    qb, kb, vb = split_cols(qkv_b, (B_W, B_W, B_W))
    qb = l2_normalize(qb.reshape(bsz, T, B_HEADS, B_HEAD_DIM))
    kb = l2_normalize(kb.reshape(bsz, T, B_HEADS, B_HEAD_DIM))
    vb = vb.reshape(bsz, T, B_HEADS, B_HEAD_DIM)
    beta = jax.nn.sigmoid(beta_logit.astype(f32))
    g = -jnp.exp(a_log.astype(f32)) * jax.nn.softplus(a_logit.astype(f32) + dt_bias.astype(f32))
    o_b = gated_delta_rule(qb, kb, vb, g, beta)
    o_b = o_b * lax.rsqrt(jnp.mean(o_b * o_b, axis=-1, keepdims=True) + NORM_EPS) * norm_w.astype(f32)
    o_b = o_b * jax.nn.silu(z.astype(f32).reshape(bsz, T, B_HEADS, B_HEAD_DIM))
    o_b = o_b.reshape(bsz, T, B_W).astype(x.dtype)
    return jnp.concatenate([o_a, o_b], axis=-1) @ w_out


def rg_lru(x, w_a, b_a, w_x, b_x, lam):
    f32 = jnp.float32
    bsz, T, W = x.shape
    xh = x.reshape(bsz, T, LRU_BLOCKS, W // LRU_BLOCKS)
    r = jax.nn.sigmoid((jnp.einsum('bthi,hij->bthj', xh, w_a).reshape(bsz, T, W) + b_a).astype(f32))
    i = jax.nn.sigmoid((jnp.einsum('bthi,hij->bthj', xh, w_x).reshape(bsz, T, W) + b_x).astype(f32))
    log_a = -LRU_C * r * jax.nn.softplus(-lam.astype(f32))
    a = jnp.exp(log_a)
    b = jnp.sqrt(-jnp.expm1(2.0 * log_a)) * (i * x.astype(f32))

    def combine(c1, c2):
        a1, b1 = c1
        a2, b2 = c2
        return a1 * a2, a2 * b1 + b2

    _, h = lax.associative_scan(combine, (a, b), axis=1)
    return h.astype(x.dtype)


def recurrent_mixer(x, w_in, conv_w, conv_b, w_a, b_a, w_x, b_x, lam, w_out):
    proj = x @ w_in
    xr, gate = split_cols(proj, (LRU_WIDTH, LRU_WIDTH))
    xr = causal_dwconv(xr, conv_w, conv_b)
    h = rg_lru(xr, w_a, b_a, w_x, b_x, lam)
    return (h * jax.nn.gelu(gate)) @ w_out


def sqrelu_mlp(x, w1, w2):
    h = jax.nn.relu(x @ w1)
    return (h * h) @ w2


def setup_inputs(seed: int = 0) -> dict:
    key = jax.random.key(seed)
    ks = jax.random.split(key, 24)
    f32 = jnp.float32

    def nrm(k, shape, scale):
        return jax.random.normal(k, shape, f32) * scale

    bw = LRU_WIDTH // LRU_BLOCKS
    x = nrm(ks[0], (BATCH, SEQ, D_MODEL), 1.0)
    hyb_w_in = nrm(ks[1], (N_HYB, D_MODEL, HYB_PROJ), D_MODEL ** -0.5)
    hyb_sinks = nrm(ks[2], (N_HYB, A_Q_HEADS), 0.5)
    hyb_conv_w = nrm(ks[3], (N_HYB, B_CONV, 3 * B_W), B_CONV ** -0.5)
    hyb_a_log = jnp.log(jax.random.uniform(ks[4], (N_HYB, B_HEADS), f32, 1.0, 16.0))
    dt = jnp.exp(jax.random.uniform(ks[5], (N_HYB, B_HEADS), f32, math.log(1e-3), math.log(1e-1)))
    hyb_dt_bias = dt + jnp.log(-jnp.expm1(-dt))
    hyb_norm_w = 1.0 + nrm(ks[6], (N_HYB, B_HEAD_DIM), 0.02)
    hyb_w_out = nrm(ks[7], (N_HYB, MIX_W, D_MODEL), DN_BETA * MIX_W ** -0.5)
    rec_w_in = nrm(ks[8], (N_REC, D_MODEL, 2 * LRU_WIDTH), D_MODEL ** -0.5)
    rec_conv_w = nrm(ks[9], (N_REC, LRU_CONV, LRU_WIDTH), LRU_CONV ** -0.5)
    rec_conv_b = nrm(ks[10], (N_REC, LRU_WIDTH), 0.02)
    rec_w_a = nrm(ks[11], (N_REC, LRU_BLOCKS, bw, bw), bw ** -0.5)
    rec_b_a = nrm(ks[12], (N_REC, LRU_WIDTH), 0.02)
    rec_w_x = nrm(ks[13], (N_REC, LRU_BLOCKS, bw, bw), bw ** -0.5)
    rec_b_x = nrm(ks[14], (N_REC, LRU_WIDTH), 0.02)
    u = jax.random.uniform(ks[15], (N_REC, LRU_WIDTH), f32, 0.9, 0.999)
    a0 = u ** (1.0 / LRU_C)
    rec_lambda = jnp.log(a0) - jnp.log1p(-a0)
    rec_w_out = nrm(ks[16], (N_REC, LRU_WIDTH, D_MODEL), DN_BETA * LRU_WIDTH ** -0.5)
    ln1_g = 1.0 + nrm(ks[17], (DEPTH, D_MODEL), 0.02)
    ln1_b = nrm(ks[18], (DEPTH, D_MODEL), 0.02)
    mlp_w1 = nrm(ks[19], (DEPTH, D_MODEL, D_FF), D_MODEL ** -0.5)
    mlp_w2 = nrm(ks[20], (DEPTH, D_FF, D_MODEL), DN_BETA * D_FF ** -0.5)
    ln2_g = 1.0 + nrm(ks[21], (DEPTH, D_MODEL), 0.02)
    ln2_b = nrm(ks[22], (DEPTH, D_MODEL), 0.02)
    return {'x': x, 'hyb_w_in': hyb_w_in, 'hyb_sinks': hyb_sinks, 'hyb_conv_w': hyb_conv_w,
            'hyb_a_log': hyb_a_log, 'hyb_dt_bias': hyb_dt_bias, 'hyb_norm_w': hyb_norm_w,
            'hyb_w_out': hyb_w_out, 'rec_w_in': rec_w_in, 'rec_conv_w': rec_conv_w,
            'rec_conv_b': rec_conv_b, 'rec_w_a': rec_w_a, 'rec_b_a': rec_b_a, 'rec_w_x': rec_w_x,
            'rec_b_x': rec_b_x, 'rec_lambda': rec_lambda, 'rec_w_out': rec_w_out,
            'ln1_g': ln1_g, 'ln1_b': ln1_b, 'mlp_w1': mlp_w1, 'mlp_w2': mlp_w2,
            'ln2_g': ln2_g, 'ln2_b': ln2_b}


def reference(x, hyb_w_in, hyb_sinks, hyb_conv_w, hyb_a_log, hyb_dt_bias, hyb_norm_w, hyb_w_out,
              rec_w_in, rec_conv_w, rec_conv_b, rec_w_a, rec_b_a, rec_w_x, rec_b_x, rec_lambda,
              rec_w_out, ln1_g, ln1_b, mlp_w1, mlp_w2, ln2_g, ln2_b):
    for layer in range(DEPTH):
        j = layer // 2
        if layer % 2 == 0:
            mix = hybrid_mixer(x, hyb_w_in[j], hyb_sinks[j], hyb_conv_w[j], hyb_a_log[j],
                               hyb_dt_bias[j], hyb_norm_w[j], hyb_w_out[j])
        else:
            mix = recurrent_mixer(x, rec_w_in[j], rec_conv_w[j], rec_conv_b[j], rec_w_a[j],
                                  rec_b_a[j], rec_w_x[j], rec_b_x[j], rec_lambda[j], rec_w_out[j])
        x = layer_norm(DN_ALPHA * x + mix, ln1_g[layer], ln1_b[layer])
        x = layer_norm(DN_ALPHA * x + sqrelu_mlp(x, mlp_w1[layer], mlp_w2[layer]), ln2_g[layer], ln2_b[layer])
    return x
```

```cpp
#include <hip/hip_runtime.h>
#include <hip/hip_cooperative_groups.h>
#include <cstdio>
#include <cstdint>
namespace cg = cooperative_groups;

#define LAS __attribute__((address_space(3)))
typedef unsigned short bf16_t;
typedef short bf16x8 __attribute__((ext_vector_type(8)));
typedef short bf16x4 __attribute__((ext_vector_type(4)));
typedef float f32x4 __attribute__((ext_vector_type(4)));
typedef float f32x2 __attribute__((ext_vector_type(2)));
typedef unsigned u32x4 __attribute__((ext_vector_type(4)));
typedef unsigned u32x2 __attribute__((ext_vector_type(2)));

constexpr int MTOK = 32768, DM = 1024, SEQ = 4096;
constexpr int HPP = 3072;
constexpr float DN_ALPHA = 1.6817928305074290f;
constexpr size_t MiB = 1024ull * 1024ull;
constexpr size_t WB_HIN = 0;
constexpr size_t WB_HOUT = WB_HIN + 2ull * 3072 * 1024 * 2;
constexpr size_t WB_RIN = WB_HOUT + 2ull * 1024 * 1024 * 2;
constexpr size_t WB_RG = WB_RIN + 2ull * 2048 * 1024 * 2;
constexpr size_t WB_ROUT = WB_RG + 2ull * 2048 * 256 * 2;
constexpr size_t WB_W1 = WB_ROUT + 2ull * 1024 * 1024 * 2;
constexpr size_t WB_W2 = WB_W1 + 4ull * 4096 * 1024 * 2;
constexpr size_t WB_END = WB_W2 + 4ull * 4096 * 1024 * 2;
static_assert(WB_END <= 96 * MiB, "weights");
constexpr size_t OFF_XB = 96 * MiB;
constexpr size_t OFF_ROPE = 160 * MiB;
constexpr size_t OFF_BAR = 161 * MiB;
constexpr size_t OFF_SCR = 162 * MiB;
constexpr size_t S_PROJ = OFF_SCR;
constexpr size_t S_BL = S_PROJ + 192 * MiB;
constexpr size_t S_QG = S_BL + 1 * MiB;
constexpr size_t S_KT = S_QG + 32 * MiB;
constexpr size_t S_W = S_KT + 32 * MiB;
constexpr size_t S_QK = S_W + 32 * MiB;
constexpr size_t S_GL = S_QK + 16 * MiB;
constexpr size_t S_PROJ2 = OFF_SCR;
constexpr size_t S_XRC = S_PROJ2 + 128 * MiB;
constexpr size_t S_LA = S_XRC + 64 * MiB;
constexpr size_t S_CLA = S_LA + 128 * MiB;
constexpr size_t S_CH = S_CLA + 2 * MiB;
constexpr size_t S_H = OFF_SCR;
constexpr size_t WS_NEED = OFF_SCR + 326 * MiB;
constexpr int LDS_BYTES = 131072;

struct Params {
    const float* x; const float* hyb_w_in; const float* hyb_sinks; const float* hyb_conv_w; const float* hyb_a_log; const float* hyb_dt_bias; const float* hyb_norm_w; const float* hyb_w_out;
    const float* rec_w_in; const float* rec_conv_w; const float* rec_conv_b; const float* rec_w_a; const float* rec_b_a; const float* rec_w_x; const float* rec_b_x; const float* rec_lambda; const float* rec_w_out;
    const float* ln1_g; const float* ln1_b; const float* mlp_w1; const float* mlp_w2; const float* ln2_g; const float* ln2_b;
    float* out; unsigned char* ws;
};

typedef const __attribute__((address_space(4))) Params* KParamsPtr;
__device__ __forceinline__ Params load_params() {
#if defined(__HIP_DEVICE_COMPILE__)
    KParamsPtr k = (KParamsPtr)__builtin_amdgcn_kernarg_segment_ptr(); asm volatile("" : "+s"(k));
    Params r; const __attribute__((address_space(4))) unsigned long long* q = (const __attribute__((address_space(4))) unsigned long long*)k; const char** d = (const char**)&r;
#pragma unroll
    for (int i = 0; i < (int)(sizeof(Params) / 8); ++i) { const __attribute__((address_space(1))) char* gp = (const __attribute__((address_space(1))) char*)q[i]; d[i] = (const char*)gp; }
    return r;
#else
    return Params{};
#endif
}
__device__ __forceinline__ int tid_fresh() { int t = threadIdx.x; asm volatile("" : "+v"(t)); return t; }
typedef __bf16 bf16x2_t __attribute__((ext_vector_type(2)));
__device__ __forceinline__ unsigned cvt_pk_bf16(float lo, float hi) { const f32x2 v = {lo, hi}; const bf16x2_t b = __builtin_convertvector(v, bf16x2_t); return __builtin_bit_cast(unsigned, b); }
__device__ __forceinline__ bf16_t f2bf(float f) { return (bf16_t)(cvt_pk_bf16(f, 0.f) & 0xffffu); }
__device__ __forceinline__ float bf2f(bf16_t b) { return __uint_as_float(((unsigned)b) << 16); }
__device__ __forceinline__ float bflo(unsigned u) { return __uint_as_float(u << 16); }
__device__ __forceinline__ float bfhi(unsigned u) { return __uint_as_float(u & 0xffff0000u); }
__device__ __forceinline__ float sigmoidf_(float x) { return 1.0f / (1.0f + __expf(-x)); }
__device__ __forceinline__ bf16x8 pack8(const f32x4 a, const f32x4 b) {
    u32x4 w; w.x = cvt_pk_bf16(a[0], a[1]); w.y = cvt_pk_bf16(a[2], a[3]); w.z = cvt_pk_bf16(b[0], b[1]); w.w = cvt_pk_bf16(b[2], b[3]);
    return __builtin_bit_cast(bf16x8, w);
}
__device__ __forceinline__ bf16x8 ldA_split(LAS unsigned char* base, int row, int col, int strideB) {
    const u32x2 lo = *(LAS u32x2*)(base + row * strideB + col * 2);
    const u32x2 hi = *(LAS u32x2*)(base + row * strideB + (col + 16) * 2);
    u32x4 w; w.x = lo.x; w.y = lo.y; w.z = hi.x; w.w = hi.y;
    return __builtin_bit_cast(bf16x8, w);
}
#define MFMA16(a, b, c) __builtin_amdgcn_mfma_f32_16x16x32_bf16((a), (b), (c), 0, 0, 0)

namespace pg8 {
constexpr int BM = 256, BK = 64, HALF = 128, HTB = HALF * BK * 2, STAGE_BYTES = 8 * HTB, NXCD = 8, WGM = 8;
__host__ __device__ __forceinline__ int lds_byte(int r, int c) { const int st = (r >> 4) * 2 + (c >> 5), rr = r & 15, cc = c & 31, ob = rr * 64 + cc * 2; return st * 1024 + (ob ^ (((ob >> 9) & 1) << 5)); }
__host__ __device__ __forceinline__ void stage_rc(int b, int& R, int& C) { const int st = b / 1024, sb = b % 1024, swz = sb ^ (((sb >> 9) & 1) << 5); R = (st >> 1) * 16 + swz / 64; C = (st & 1) * 32 + (swz % 64) / 2; }
__host__ __device__ __forceinline__ int perm32(int rho) { const int n = rho >> 4, i = rho & 15; return 8 * (i >> 2) + 4 * n + (i & 3); }

struct Unit { int pm, pn, ka; };
struct Gemm { const bf16_t* A; const bf16_t* Bt; int M, N, K, lda; };

struct Order {
    int nM, nN, nwg, G, c, gates;
    __device__ void init(int M, int N, int G_, int c_, int gates_) { nM = M / BM; nN = N / BM; nwg = nM * nN; G = G_; c = c_; gates = gates_; }
    __device__ bool next(int i, Unit& u) const {
        const long L = (long)i * G + c; if (L >= nwg) return false;
        int wgid = (int)L; { const int q = nwg / NXCD, r = nwg % NXCD, xcd = wgid % NXCD, off = wgid / NXCD; wgid = (xcd < r ? xcd * (q + 1) : r * (q + 1) + (xcd - r) * q) + off; }
        const int nig = WGM * nN, gid = wgid / nig, fm = gid * WGM, gsz = (nM - fm) < WGM ? (nM - fm) : WGM;
        u.pm = fm + ((wgid % nig) % gsz); u.pn = (wgid % nig) / gsz; u.ka = gates ? (u.pn >> 1) * 256 : 0; return true;
    }
};

template <class Epi>
__device__ __forceinline__ void gemm_phase(LAS unsigned char* lds, const Gemm g, const Order& S, const Epi& E) {
    const int tid = tid_fresh(), wid = __builtin_amdgcn_readfirstlane(tid >> 6), lane = tid & 63, wr = wid >> 2, wc = wid & 3, fr = lane & 15, fq = lane >> 4;
    const int K = g.K, nt = K / BK;
    unsigned voffA[2], voffB[2];
#pragma unroll
    for (int i = 0; i < 2; ++i) { int R, C; stage_rc(tid * 16 + i * 8192, R, C); const int Rb = Epi::PERM ? ((R & ~31) + perm32(R & 31)) : R;
        voffA[i] = (unsigned)(R * g.lda + C) * 2u; voffB[i] = (unsigned)(Rb * K + C) * 2u; }
    const size_t kstep = (size_t)(BK * 2);
    const size_t hstepA = (size_t)HALF * g.lda * 2, hstepB = (size_t)HALF * K * 2;
    const size_t tstepA = 2 * hstepA, tstepB = 2 * hstepB;
    const unsigned ldsw = (unsigned)wid * 1024u;
    const int aoff = lds_byte(wr * 64 + fr, fq * 8), boff = lds_byte(wc * 32 + fr, fq * 8);
#define PG8_SA(b, h) (((b) * 2 + (h)) * HTB)
#define PG8_SB(b, h) ((4 + (b) * 2 + (h)) * HTB)
#define PG8_STAGE(bufoff, gbase, voff) do { _Pragma("unroll") for (int _i = 0; _i < 2; ++_i) \
        __builtin_amdgcn_global_load_lds((const unsigned*)((const char*)(gbase) + (voff)[_i]), (LAS unsigned*)(lds + (bufoff) + ldsw + _i * 8192), 16, 0, 0); } while (0)
#define PG8_LDA(dst, b, h) do { _Pragma("unroll") for (int m = 0; m < 4; ++m) _Pragma("unroll") for (int k = 0; k < 2; ++k) dst[m][k] = *(const LAS bf16x8*)(lds + PG8_SA(b, h) + aoff + m * 2048 + k * 1024); } while (0)
#define PG8_LDB(dst, b, h) do { _Pragma("unroll") for (int n = 0; n < 2; ++n) _Pragma("unroll") for (int k = 0; k < 2; ++k) dst[n][k] = *(const LAS bf16x8*)(lds + PG8_SB(b, h) + boff + n * 2048 + k * 1024); } while (0)
#define PG8_MMA(ai, bj, At, Bt) do { __builtin_amdgcn_s_setprio(1); _Pragma("unroll") for (int m = 0; m < 4; ++m) _Pragma("unroll") for (int n = 0; n < 2; ++n) _Pragma("unroll") for (int k = 0; k < 2; ++k) \
        acc[ai][bj][m][n] = __builtin_amdgcn_mfma_f32_16x16x32_bf16(Bt[n][k], At[m][k], acc[ai][bj][m][n], 0, 0, 0); __builtin_amdgcn_s_setprio(0); } while (0)
#define PG8_WAIT_V(n) asm volatile("s_waitcnt vmcnt(" #n ")" ::: "memory")
#define PG8_WAIT_L(n) asm volatile("s_waitcnt lgkmcnt(" #n ")" ::: "memory")
#define PG8_BAR __builtin_amdgcn_s_barrier()
#define PG8_SCHED __builtin_amdgcn_sched_barrier(0)
    Unit cur, nxt; int ui = 0;
    if (!S.next(0, cur)) return;
    f32x4 acc[2][2][4][2];
#pragma unroll
    for (int a = 0; a < 2; ++a)
#pragma unroll
        for (int b = 0; b < 2; ++b)
#pragma unroll
            for (int m = 0; m < 4; ++m)
#pragma unroll
                for (int n = 0; n < 2; ++n) acc[a][b][m][n] = (f32x4){0.f, 0.f, 0.f, 0.f};
    bf16x8 At[4][2], B0[2][2], B1[2][2];
    const char* cA = (const char*)g.A + (size_t)cur.pm * tstepA + (size_t)cur.ka * 2; const char* cB = (const char*)g.Bt + (size_t)cur.pn * tstepB;
    PG8_STAGE(PG8_SB(0, 0), cB, voffB); PG8_STAGE(PG8_SA(0, 0), cA, voffA); PG8_STAGE(PG8_SB(0, 1), cB + hstepB, voffB); PG8_STAGE(PG8_SA(0, 1), cA + hstepA, voffA);
    if (wr == 1) PG8_BAR;
    PG8_WAIT_V(4); PG8_BAR;
    PG8_STAGE(PG8_SB(1, 0), cB + kstep, voffB); PG8_STAGE(PG8_SA(1, 0), cA + kstep, voffA); PG8_STAGE(PG8_SB(1, 1), cB + hstepB + kstep, voffB);
    PG8_WAIT_V(6); PG8_BAR;
    for (;;) {
        const bool has_next = S.next(ui + 1, nxt);
        const char* nA = has_next ? (const char*)g.A + (size_t)nxt.pm * tstepA + (size_t)nxt.ka * 2 : cA; const char* nB = has_next ? (const char*)g.Bt + (size_t)nxt.pn * tstepB : cB;
        for (int t = 0; t < nt; t += 2) {
            const bool last = (t == nt - 2);
            const char* a1 = cA + (size_t)(t + 1) * kstep;
            const char* a2 = last ? nA : cA + (size_t)(t + 2) * kstep; const char* b2 = last ? nB : cB + (size_t)(t + 2) * kstep;
            const char* a3 = a2 + kstep; const char* b3 = b2 + kstep;
            PG8_LDB(B0, 0, 0); PG8_SCHED; PG8_LDA(At, 0, 0); PG8_STAGE(PG8_SA(1, 1), a1 + hstepA, voffA);
            PG8_WAIT_L(8); PG8_BAR; PG8_WAIT_L(0); PG8_MMA(0, 0, At, B0); PG8_BAR; PG8_SCHED;
            PG8_LDB(B1, 0, 1); PG8_STAGE(PG8_SB(0, 0), b2, voffB);
            PG8_BAR; PG8_WAIT_L(0); PG8_MMA(0, 1, At, B1); PG8_BAR;
            PG8_LDA(At, 0, 1); PG8_STAGE(PG8_SA(0, 0), a2, voffA);
            PG8_BAR; PG8_WAIT_L(0); PG8_MMA(1, 0, At, B0); PG8_BAR; PG8_SCHED;
            PG8_STAGE(PG8_SB(0, 1), b2 + hstepB, voffB);
            PG8_WAIT_V(6); PG8_BAR; PG8_MMA(1, 1, At, B1); PG8_BAR;
            PG8_LDB(B0, 1, 0); PG8_SCHED; PG8_LDA(At, 1, 0); PG8_STAGE(PG8_SA(0, 1), a2 + hstepA, voffA);
            PG8_WAIT_L(8); PG8_BAR; PG8_WAIT_L(0); PG8_MMA(0, 0, At, B0); PG8_BAR; PG8_SCHED;
            PG8_LDB(B1, 1, 1); PG8_STAGE(PG8_SB(1, 0), b3, voffB);
            PG8_BAR; PG8_WAIT_L(0); PG8_MMA(0, 1, At, B1); PG8_BAR;
            PG8_LDA(At, 1, 1); PG8_STAGE(PG8_SA(1, 0), a3, voffA);
            PG8_BAR; PG8_WAIT_L(0); PG8_MMA(1, 0, At, B0); PG8_BAR; PG8_SCHED;
            PG8_STAGE(PG8_SB(1, 1), b3 + hstepB, voffB);
            PG8_WAIT_V(6); PG8_BAR; PG8_MMA(1, 1, At, B1); PG8_BAR;
        }
        E(acc, cur, wr, wc, fr, fq);
        if (!has_next) break;
#pragma unroll
        for (int a = 0; a < 2; ++a)
#pragma unroll
            for (int b = 0; b < 2; ++b)
#pragma unroll
                for (int m = 0; m < 4; ++m)
#pragma unroll
                    for (int n = 0; n < 2; ++n) acc[a][b][m][n] = (f32x4){0.f, 0.f, 0.f, 0.f};
        cur = nxt; cA = nA; cB = nB; ++ui;
    }
    PG8_WAIT_V(0);
    if (wr == 0) PG8_BAR;
    PG8_BAR;
#undef PG8_SA
#undef PG8_SB
#undef PG8_STAGE
#undef PG8_LDA
#undef PG8_LDB
#undef PG8_MMA
#undef PG8_WAIT_V
#undef PG8_WAIT_L
#undef PG8_BAR
#undef PG8_SCHED
}

typedef const f32x4 (&AccRef)[2][2][4][2];
template <int ACT> struct EpiBf16 {
    static constexpr bool PERM = true;
    bf16_t* O; int ldc;
    __device__ __forceinline__ void operator()(AccRef acc, const Unit& u, int wr, int wc, int fr, int fq) const {
        const int row0 = u.pm * BM + wr * 64 + fr, col0 = u.pn * BM + wc * 32 + 8 * fq;
#pragma unroll
        for (int ai = 0; ai < 2; ++ai)
#pragma unroll
            for (int m = 0; m < 4; ++m) { bf16_t* rowp = O + (size_t)(row0 + ai * HALF + m * 16) * ldc + col0;
#pragma unroll
                for (int bj = 0; bj < 2; ++bj) { f32x4 v0 = acc[ai][bj][m][0], v1 = acc[ai][bj][m][1];
                    if (ACT == 1) {
#pragma unroll
                        for (int j = 0; j < 4; ++j) { const float a = fmaxf(v0[j], 0.f), b = fmaxf(v1[j], 0.f); v0[j] = a * a; v1[j] = b * b; } }
                    u32x4 w; w.x = cvt_pk_bf16(v0[0], v0[1]); w.y = cvt_pk_bf16(v0[2], v0[3]); w.z = cvt_pk_bf16(v1[0], v1[1]); w.w = cvt_pk_bf16(v1[2], v1[3]);
                    *(u32x4*)(rowp + bj * HALF) = w; } }
    }
};
struct EpiProjHyb {
    static constexpr bool PERM = true;
    bf16_t* O; float* BL;
    __device__ __forceinline__ void operator()(AccRef acc, const Unit& u, int wr, int wc, int fr, int fq) const {
        const int row0 = u.pm * BM + wr * 64 + fr;
        if (u.pn == 11) {
            if (wc == 0 && fq == 0) {
#pragma unroll
                for (int ai = 0; ai < 2; ++ai)
#pragma unroll
                    for (int m = 0; m < 4; ++m) { float* bp = BL + (size_t)(row0 + ai * HALF + m * 16) * 8; *(f32x4*)bp = acc[ai][0][m][0]; *(f32x4*)(bp + 4) = acc[ai][0][m][1]; }
            }
            return;
        }
        const int col0 = u.pn * BM + wc * 32 + 8 * fq;
#pragma unroll
        for (int ai = 0; ai < 2; ++ai)
#pragma unroll
            for (int m = 0; m < 4; ++m) { bf16_t* rowp = O + (size_t)(row0 + ai * HALF + m * 16) * HPP + col0;
#pragma unroll
                for (int bj = 0; bj < 2; ++bj) { const f32x4 v0 = acc[ai][bj][m][0], v1 = acc[ai][bj][m][1];
                    u32x4 w; w.x = cvt_pk_bf16(v0[0], v0[1]); w.y = cvt_pk_bf16(v0[2], v0[3]); w.z = cvt_pk_bf16(v1[0], v1[1]); w.w = cvt_pk_bf16(v1[2], v1[3]);
                    *(u32x4*)(rowp + bj * HALF) = w; } }
    }
};
struct EpiResid {
    static constexpr bool PERM = false;
    const bf16_t* XB; float* Y;
    __device__ __forceinline__ void operator()(AccRef acc, const Unit& u, int wr, int wc, int fr, int fq) const {
        const int row0 = u.pm * BM + wr * 64 + fr, col0 = u.pn * BM + wc * 32 + 4 * fq;
#pragma unroll
        for (int ai = 0; ai < 2; ++ai)
#pragma unroll
            for (int m = 0; m < 4; ++m) { const size_t off = (size_t)(row0 + ai * HALF + m * 16) * DM + col0;
#pragma unroll
                for (int bj = 0; bj < 2; ++bj)
#pragma unroll
                    for (int n = 0; n < 2; ++n) { const size_t o = off + bj * HALF + n * 16; const u32x2 xv = *(const u32x2*)(XB + o);
                        f32x4 r; r[0] = DN_ALPHA * bflo(xv.x) + acc[ai][bj][m][n][0]; r[1] = DN_ALPHA * bfhi(xv.x) + acc[ai][bj][m][n][1];
                        r[2] = DN_ALPHA * bflo(xv.y) + acc[ai][bj][m][n][2]; r[3] = DN_ALPHA * bfhi(xv.y) + acc[ai][bj][m][n][3];
                        *(f32x4*)(Y + o) = r; } }
    }
};
}

__device__ __forceinline__ void transpose_tile(const float* __restrict__ src, int ld, int K, int Nvalid, bf16_t* __restrict__ dst, int k0, int n0, LAS float* tile, const int tid) {
    { const int n = tid & 63, kk = tid >> 6;
#pragma unroll
      for (int i = 0; i < 8; ++i) { const int k = kk + 8 * i; tile[k * 65 + n] = (n0 + n < Nvalid) ? src[(size_t)(k0 + k) * ld + n0 + n] : 0.f; } }
    __syncthreads();
    { const int k2 = (tid & 31) * 2, nn = tid >> 5;
#pragma unroll
      for (int i = 0; i < 4; ++i) { const int n = nn + 16 * i; *(unsigned*)(dst + (size_t)(n0 + n) * K + k0 + k2) = cvt_pk_bf16(tile[k2 * 65 + n], tile[(k2 + 1) * 65 + n]); } }
    __syncthreads();
}

__device__ __forceinline__ void prep_phase(LAS unsigned char* lds) {
    const Params p = load_params();
    const int tid = tid_fresh(), G = gridDim.x;
    const size_t gtid = (size_t)blockIdx.x * 512 + tid, gsz = (size_t)G * 512;
    {
        const f32x4* src = (const f32x4*)p.x; u32x2* dst = (u32x2*)(p.ws + OFF_XB);
        const size_t n4 = (size_t)MTOK * DM / 4;
        for (size_t i = gtid; i < n4; i += gsz) { const f32x4 v = src[i]; u32x2 w; w.x = cvt_pk_bf16(v[0], v[1]); w.y = cvt_pk_bf16(v[2], v[3]); dst[i] = w; }
    }
    {
        float* rope = (float*)(p.ws + OFF_ROPE);
        for (size_t i = gtid; i < (size_t)SEQ * 32; i += gsz) { const int t = (int)(i >> 5), j = (int)(i & 31);
            const float inv = (float)exp(-(double)j * (9.210340371976184 / 32.0)); const float ang = (float)t * inv;
            double s, c; sincos((double)ang, &s, &c); rope[i * 2] = (float)c; rope[i * 2 + 1] = (float)s; }
    }
    LAS float* tile = (LAS float*)lds;
    int base = 0;
    for (int j = 0; j < 17; ++j) {
        const float* src = nullptr; bf16_t* dst = nullptr; int ld = 0, K = 0, N = 0, Np = 0, ntiles;
        if (j < 2) { src = p.hyb_w_in + (size_t)j * 1024 * 2824; ld = 2824; K = 1024; N = 2824; Np = 3072; dst = (bf16_t*)(p.ws + WB_HIN) + (size_t)j * 3072 * 1024; }
        else if (j < 4) { const int l = j - 2; src = p.hyb_w_out + (size_t)l * 1024 * 1024; ld = 1024; K = 1024; N = 1024; Np = 1024; dst = (bf16_t*)(p.ws + WB_HOUT) + (size_t)l * 1024 * 1024; }
        else if (j < 6) { const int l = j - 4; src = p.rec_w_in + (size_t)l * 1024 * 2048; ld = 2048; K = 1024; N = 2048; Np = 2048; dst = (bf16_t*)(p.ws + WB_RIN) + (size_t)l * 2048 * 1024; }
        else if (j < 8) { const int l = j - 6; src = p.rec_w_out + (size_t)l * 1024 * 1024; ld = 1024; K = 1024; N = 1024; Np = 1024; dst = (bf16_t*)(p.ws + WB_ROUT) + (size_t)l * 1024 * 1024; }
        else if (j < 12) { const int l = j - 8; src = p.mlp_w1 + (size_t)l * 1024 * 4096; ld = 4096; K = 1024; N = 4096; Np = 4096; dst = (bf16_t*)(p.ws + WB_W1) + (size_t)l * 4096 * 1024; }
        else if (j < 16) { const int l = j - 12; src = p.mlp_w2 + (size_t)l * 4096 * 1024; ld = 1024; K = 4096; N = 1024; Np = 1024; dst = (bf16_t*)(p.ws + WB_W2) + (size_t)l * 1024 * 4096; }
        ntiles = (j < 16) ? (K / 64) * (Np / 64) : 256;
        for (int t = ((int)blockIdx.x - base % G + G) % G; t < ntiles; t += G) {
            if (j < 16) { const int kt = t % (K / 64), ntl = t / (K / 64); transpose_tile(src, ld, K, N, dst, kt * 64, ntl * 64, tile, tid); }
            else {
                const int idx = t >> 3, sub = t & 7, kt = sub & 3, ntl = sub >> 2, l = idx >> 4, pn = (idx >> 1) & 7, gg = idx & 1, h = pn >> 1, hh = pn & 1;
                const float* s2 = (gg ? p.rec_w_x : p.rec_w_a) + (size_t)l * 4 * 65536 + (size_t)h * 65536 + hh * 128;
                bf16_t* d2 = (bf16_t*)(p.ws + WB_RG) + (size_t)l * 2048 * 256 + (size_t)(pn * 256 + gg * 128) * 256;
                transpose_tile(s2, 256, 256, 128, d2, kt * 64, ntl * 64, tile, tid);
            }
        }
        base += ntiles;
    }
}

__device__ __forceinline__ void ln_phase(const float* Y, const float* __restrict__ g, const float* __restrict__ b, bf16_t* xb, float* outf) {
    const int tid = tid_fresh(); const int wave = tid >> 6, lane = tid & 63;
    f32x4 gv[4], bv[4];
#pragma unroll
    for (int j = 0; j < 4; ++j) { gv[j] = *(const f32x4*)(g + j * 256 + lane * 4); bv[j] = *(const f32x4*)(b + j * 256 + lane * 4); }
    for (int row = blockIdx.x * 8 + wave; row < MTOK; row += gridDim.x * 8) {
        const float* yr = Y + (size_t)row * DM;
        f32x4 v[4];
#pragma unroll
        for (int j = 0; j < 4; ++j) v[j] = *(const f32x4*)(yr + j * 256 + lane * 4);
        float s = 0.f;
#pragma unroll
        for (int j = 0; j < 4; ++j) s += (v[j][0] + v[j][1]) + (v[j][2] + v[j][3]);
#pragma unroll
        for (int o = 32; o >= 1; o >>= 1) s += __shfl_xor(s, o);
        const float mean = s * (1.0f / 1024.0f);
        float q = 0.f;
#pragma unroll
        for (int j = 0; j < 4; ++j) { const f32x4 d = v[j] - mean; q += (d[0] * d[0] + d[1] * d[1]) + (d[2] * d[2] + d[3] * d[3]); }
#pragma unroll
        for (int o = 32; o >= 1; o >>= 1) q += __shfl_xor(q, o);
        const float rstd = rsqrtf(q * (1.0f / 1024.0f) + 1e-5f);
#pragma unroll
        for (int j = 0; j < 4; ++j) { const f32x4 o = (v[j] - mean) * rstd * gv[j] + bv[j];
            if (outf) *(f32x4*)(outf + (size_t)row * DM + j * 256 + lane * 4) = o;
            else { u32x2 w; w.x = cvt_pk_bf16(o[0], o[1]); w.y = cvt_pk_bf16(o[2], o[3]); *(u32x2*)(xb + (size_t)row * DM + j * 256 + lane * 4) = w; } }
    }
}

__device__ __forceinline__ void rconv_phase(const bf16_t* proj2, const float* __restrict__ cw, const float* __restrict__ cb, bf16_t* xrc) {
    const int tid = tid_fresh();
    for (int it = blockIdx.x * 512 + tid; it < 131072; it += gridDim.x * 512) {
        const int cgp = it & 127, seg = (it >> 7) & 127, b = it >> 14, c0 = cgp * 8, t0 = seg * 32;
        float w[4][8], bias[8], xw[3][8];
#pragma unroll
        for (int j = 0; j < 4; ++j) { const f32x4 a = *(const f32x4*)(cw + j * 1024 + c0), c = *(const f32x4*)(cw + j * 1024 + c0 + 4);
#pragma unroll
            for (int d = 0; d < 4; ++d) { w[j][d] = a[d]; w[j][4 + d] = c[d]; } }
        { const f32x4 a = *(const f32x4*)(cb + c0), c = *(const f32x4*)(cb + c0 + 4);
#pragma unroll
          for (int d = 0; d < 4; ++d) { bias[d] = a[d]; bias[4 + d] = c[d]; } }
#pragma unroll
        for (int j = 0; j < 3; ++j) { const int t = t0 - 3 + j;
            u32x4 v = (u32x4){0u, 0u, 0u, 0u};
            if (t >= 0) v = *(const u32x4*)(proj2 + (size_t)(b * SEQ + t) * 2048 + c0);
            xw[j][0] = bflo(v.x); xw[j][1] = bfhi(v.x); xw[j][2] = bflo(v.y); xw[j][3] = bfhi(v.y); xw[j][4] = bflo(v.z); xw[j][5] = bfhi(v.z); xw[j][6] = bflo(v.w); xw[j][7] = bfhi(v.w); }
#pragma unroll 4
        for (int t = 0; t < 32; ++t) {
            const u32x4 v = *(const u32x4*)(proj2 + (size_t)(b * SEQ + t0 + t) * 2048 + c0);
            const float x3[8] = {bflo(v.x), bfhi(v.x), bflo(v.y), bfhi(v.y), bflo(v.z), bfhi(v.z), bflo(v.w), bfhi(v.w)};
            float y[8];
#pragma unroll
            for (int d = 0; d < 8; ++d) { y[d] = bias[d] + w[0][d] * xw[0][d] + w[1][d] * xw[1][d] + w[2][d] * xw[2][d] + w[3][d] * x3[d]; xw[0][d] = xw[1][d]; xw[1][d] = xw[2][d]; xw[2][d] = x3[d]; }
            u32x4 o; o.x = cvt_pk_bf16(y[0], y[1]); o.y = cvt_pk_bf16(y[2], y[3]); o.z = cvt_pk_bf16(y[4], y[5]); o.w = cvt_pk_bf16(y[6], y[7]);
            *(u32x4*)(xrc + (size_t)(b * SEQ + t0 + t) * DM + c0) = o;
        }
    }
}
__device__ __forceinline__ void lru_ab(float ra, float ix, float x, float sp, float& a, float& b) {
    const float r = sigmoidf_(ra), ig = sigmoidf_(ix), l = r * sp, x2 = 2.0f * l;
    a = __expf(l);
    const float om = (x2 > -0.25f) ? -x2 * (1.0f + x2 * (0.5f + x2 * (0.16666667f + x2 * (0.041666668f + x2 * (0.0083333333f + x2 * 0.0013888889f))))) : 1.0f - a * a;
    b = sqrtf(fmaxf(om, 0.f)) * (ig * x);
}
__device__ __forceinline__ float softplus_neg8(float lm) { const float e = __expf(-lm); const float l1 = (e < 0.03f) ? e * (1.0f - e * (0.5f - e * (0.33333333f - 0.25f * e))) : __logf(1.0f + e); return -8.0f * l1; }
__device__ __forceinline__ float gelu_tanh(float x) { const float u = 0.7978845608028654f * (x + 0.044715f * x * x * x); const float t = 1.0f - 2.0f / (1.0f + __expf(2.0f * u)); return 0.5f * x * (1.0f + t); }
template <int PASS>
__device__ __forceinline__ void rscan_phase(const bf16_t* GB, const bf16_t* xrc, const float* __restrict__ b_a, const float* __restrict__ b_x, const float* __restrict__ lam, float* CLA, float* CH, bf16_t* proj2) {
    const int tid = tid_fresh();
    for (int it = blockIdx.x * 512 + tid; it < 8 * 64 * 512; it += gridDim.x * 512) {
        const int cp = it & 511, seg = (it >> 9) & 63, b = it >> 15, c = 2 * cp, gcol = (c >> 7) * 256 + (c & 127);
        const float ba0 = b_a[c], ba1 = b_a[c + 1], bx0 = b_x[c], bx1 = b_x[c + 1], sp0 = softplus_neg8(lam[c]), sp1 = softplus_neg8(lam[c + 1]);
        float h0 = 0.f, h1 = 0.f, sl0 = 0.f, sl1 = 0.f;
        if (PASS == 2) {
            for (int s = 0; s < seg; ++s) { const int ci = (b * 64 + s) * 1024 + c; const f32x2 la = *(const f32x2*)(CLA + ci), hh = *(const f32x2*)(CH + ci);
                h0 = __expf(la[0]) * h0 + hh[0]; h1 = __expf(la[1]) * h1 + hh[1]; }
        }
        const size_t row0 = (size_t)(b * SEQ + seg * 64);
        for (int t0 = 0; t0 < 64; t0 += 8) {
            unsigned ga[8], gx[8], xv[8], gt[8];
#pragma unroll
            for (int t = 0; t < 8; ++t) { const size_t row = row0 + t0 + t;
                ga[t] = *(const unsigned*)(GB + row * 2048 + gcol); gx[t] = *(const unsigned*)(GB + row * 2048 + gcol + 128); xv[t] = *(const unsigned*)(xrc + row * DM + c);
                if (PASS == 2) gt[t] = *(const unsigned*)(proj2 + row * 2048 + 1024 + c); }
#pragma unroll
            for (int t = 0; t < 8; ++t) { float a0, b0, a1, b1;
                lru_ab(bflo(ga[t]) + ba0, bflo(gx[t]) + bx0, bflo(xv[t]), sp0, a0, b0);
                lru_ab(bfhi(ga[t]) + ba1, bfhi(gx[t]) + bx1, bfhi(xv[t]), sp1, a1, b1);
                h0 = a0 * h0 + b0; h1 = a1 * h1 + b1;
                if (PASS == 1) { sl0 += __logf(a0); sl1 += __logf(a1); }
                else *(unsigned*)(proj2 + (row0 + t0 + t) * 2048 + c) = cvt_pk_bf16(h0 * gelu_tanh(bflo(gt[t])), h1 * gelu_tanh(bfhi(gt[t]))); }
        }
        if (PASS == 1) { const int ci = (b * 64 + seg) * 1024 + c; *(f32x2*)(CLA + ci) = (f32x2){sl0, sl1}; *(f32x2*)(CH + ci) = (f32x2){h0, h1}; }
    }
}

__device__ __forceinline__ void dn_local_phase(LAS unsigned char* lds, int lj) {
    const Params p = load_params();
    const int tid = tid_fresh(), wid = tid >> 6, lane = tid & 63, fr = lane & 15, fq = lane >> 4;
    const bf16_t* proj = (const bf16_t*)(p.ws + S_PROJ); const float* BL = (const float*)(p.ws + S_BL);
    bf16_t* QGg = (bf16_t*)(p.ws + S_QG); bf16_t* KTg = (bf16_t*)(p.ws + S_KT); bf16_t* Wg = (bf16_t*)(p.ws + S_W); bf16_t* QKg = (bf16_t*)(p.ws + S_QK);
    float* GLg = (float*)(p.ws + S_GL); float* Ug = p.out;
    const float* cw = p.hyb_conv_w + (size_t)lj * 4 * 1536;
    LAS unsigned char* Kb = lds + 16896; LAS unsigned char* Qb = lds + 34304;
    LAS float* RHS = (LAS float*)(lds + 51712); LAS float* AM = (LAS float*)lds; LAS float* Gs = (LAS float*)(lds + 16384); LAS float* Bs = (LAS float*)(lds + 16640);
    for (int it = blockIdx.x; it < 2048; it += gridDim.x) {
        const int n = it & 63, h = (it >> 6) & 3, b = it >> 8;
        const int rowbase = b * SEQ + n * 64;
        if (wid == 0) {
            const float bl = BL[(size_t)(rowbase + lane) * 8 + h], al = BL[(size_t)(rowbase + lane) * 8 + 4 + h];
            const float beta = sigmoidf_(bl); const float xx = al + p.hyb_dt_bias[lj * 4 + h];
            const float sp = xx > 20.f ? xx : log1pf(__expf(xx));
            float g = -__expf(p.hyb_a_log[lj * 4 + h]) * sp;
#pragma unroll
            for (int o = 1; o < 64; o <<= 1) { const float t = __shfl_up(g, o); if (lane >= o) g += t; }
            Gs[lane] = g; Bs[lane] = beta;
            if (lane == 63) GLg[it] = g;
        }
        __syncthreads();
        {
            const int r = tid >> 3, sub = tid & 7, t = n * 64 + r;
            float y[3][16];
#pragma unroll
            for (int part = 0; part < 3; ++part) {
                const int col0 = 768 + part * 512 + h * 128 + sub * 16, c0 = part * 512 + h * 128 + sub * 16;
#pragma unroll
                for (int d = 0; d < 16; ++d) y[part][d] = 0.f;
#pragma unroll
                for (int j = 0; j < 4; ++j) { const int tt = t - 3 + j;
                    if (tt >= 0) { const bf16_t* xp = proj + (size_t)(b * SEQ + tt) * HPP + col0; const u32x4 v0 = *(const u32x4*)xp, v1 = *(const u32x4*)(xp + 8);
                        const float xs[16] = {bflo(v0.x), bfhi(v0.x), bflo(v0.y), bfhi(v0.y), bflo(v0.z), bfhi(v0.z), bflo(v0.w), bfhi(v0.w), bflo(v1.x), bfhi(v1.x), bflo(v1.y), bfhi(v1.y), bflo(v1.z), bfhi(v1.z), bflo(v1.w), bfhi(v1.w)};
                        const float* wp = cw + j * 1536 + c0;
#pragma unroll
                        for (int d4 = 0; d4 < 4; ++d4) { const f32x4 wv = *(const f32x4*)(wp + d4 * 4);
#pragma unroll
                            for (int e = 0; e < 4; ++e) y[part][d4 * 4 + e] += wv[e] * xs[d4 * 4 + e]; } } }
#pragma unroll
                for (int d = 0; d < 16; ++d) y[part][d] = y[part][d] * sigmoidf_(y[part][d]);
            }
            float sq = 0.f, sk = 0.f;
#pragma unroll
            for (int d = 0; d < 16; ++d) { sq += y[0][d] * y[0][d]; sk += y[1][d] * y[1][d]; }
#pragma unroll
            for (int o = 1; o < 8; o <<= 1) { sq += __shfl_xor(sq, o); sk += __shfl_xor(sk, o); }
            const float rq = rsqrtf(sq + 1e-6f) * 0.08838834764831845f, rk = rsqrtf(sk + 1e-6f);
            const float Gr = Gs[r], Gl = Gs[63], eg = __expf(Gr), et = __expf(Gl - Gr), beta = Bs[r];
            float qn[16], kn[16];
#pragma unroll
            for (int d = 0; d < 16; ++d) { qn[d] = y[0][d] * rq; kn[d] = y[1][d] * rk; }
            { u32x4 a, c;
              a.x = cvt_pk_bf16(qn[0], qn[1]); a.y = cvt_pk_bf16(qn[2], qn[3]); a.z = cvt_pk_bf16(qn[4], qn[5]); a.w = cvt_pk_bf16(qn[6], qn[7]);
              c.x = cvt_pk_bf16(qn[8], qn[9]); c.y = cvt_pk_bf16(qn[10], qn[11]); c.z = cvt_pk_bf16(qn[12], qn[13]); c.w = cvt_pk_bf16(qn[14], qn[15]);
              *(LAS u32x4*)(Qb + r * 272 + sub * 32) = a; *(LAS u32x4*)(Qb + r * 272 + sub * 32 + 16) = c;
              a.x = cvt_pk_bf16(kn[0], kn[1]); a.y = cvt_pk_bf16(kn[2], kn[3]); a.z = cvt_pk_bf16(kn[4], kn[5]); a.w = cvt_pk_bf16(kn[6], kn[7]);
              c.x = cvt_pk_bf16(kn[8], kn[9]); c.y = cvt_pk_bf16(kn[10], kn[11]); c.z = cvt_pk_bf16(kn[12], kn[13]); c.w = cvt_pk_bf16(kn[14], kn[15]);
              *(LAS u32x4*)(Kb + r * 272 + sub * 32) = a; *(LAS u32x4*)(Kb + r * 272 + sub * 32 + 16) = c;
              a.x = cvt_pk_bf16(qn[0] * eg, qn[1] * eg); a.y = cvt_pk_bf16(qn[2] * eg, qn[3] * eg); a.z = cvt_pk_bf16(qn[4] * eg, qn[5] * eg); a.w = cvt_pk_bf16(qn[6] * eg, qn[7] * eg);
              c.x = cvt_pk_bf16(qn[8] * eg, qn[9] * eg); c.y = cvt_pk_bf16(qn[10] * eg, qn[11] * eg); c.z = cvt_pk_bf16(qn[12] * eg, qn[13] * eg); c.w = cvt_pk_bf16(qn[14] * eg, qn[15] * eg);
              bf16_t* qp = QGg + (size_t)it * 8192 + r * 128 + sub * 16; *(u32x4*)qp = a; *(u32x4*)(qp + 8) = c; }
            bf16_t* ktp = KTg + (size_t)it * 8192;
#pragma unroll
            for (int d = 0; d < 16; ++d) {
                RHS[r * 256 + sub * 16 + d] = y[2][d] * beta;
                RHS[r * 256 + 128 + sub * 16 + d] = kn[d] * beta * eg;
                ktp[(sub * 16 + d) * 64 + r] = f2bf(kn[d] * et);
            }
        }
        __syncthreads();
        {
            const int ti = wid >> 1, isqk = wid & 1;
            LAS unsigned char* Xb = isqk ? Qb : Kb;
            bf16_t* qkp = QKg + (size_t)it * 4096;
#pragma unroll
            for (int tj = 0; tj < 4; ++tj) {
                if (tj <= ti) {
                    f32x4 acc = (f32x4){0.f, 0.f, 0.f, 0.f};
#pragma unroll
                    for (int ks = 0; ks < 4; ++ks) {
                        const bf16x8 a = *(LAS bf16x8*)(Xb + (ti * 16 + fr) * 272 + ks * 64 + fq * 16);
                        const bf16x8 bb = *(LAS bf16x8*)(Kb + (tj * 16 + fr) * 272 + ks * 64 + fq * 16);
                        acc = MFMA16(a, bb, acc);
                    }
                    const int j = tj * 16 + fr; const float Gj = Gs[j];
#pragma unroll
                    for (int e = 0; e < 4; ++e) { const int i = ti * 16 + 4 * fq + e; const float dec = __expf(fminf(Gs[i] - Gj, 0.f));
                        if (isqk) qkp[i * 64 + j] = (i >= j) ? f2bf(acc[e] * dec) : (bf16_t)0;
                        else AM[i * 64 + j] = (i > j) ? Bs[i] * acc[e] * dec : 0.f; }
                } else if (isqk) {
                    const int j = tj * 16 + fr;
#pragma unroll
                    for (int e = 0; e < 4; ++e) qkp[(ti * 16 + 4 * fq + e) * 64 + j] = (bf16_t)0;
                }
            }
        }
        __syncthreads();
        if (tid < 256) {
            const int c = tid;
            LAS float* RHSc = RHS + c;
            float X[64];
#pragma unroll
            for (int i = 0; i < 64; ++i) {
                float a0 = RHSc[i * 256], a1 = 0.f, a2 = 0.f, a3 = 0.f;
#pragma unroll
                for (int j4 = 0; j4 < (i + 3) / 4; ++j4) {
                    const f32x4 av = *(LAS f32x4*)(AM + i * 64 + j4 * 4);
                    if (j4 * 4 + 0 < i) a0 -= av[0] * X[j4 * 4 + 0];
                    if (j4 * 4 + 1 < i) a1 -= av[1] * X[j4 * 4 + 1];
                    if (j4 * 4 + 2 < i) a2 -= av[2] * X[j4 * 4 + 2];
                    if (j4 * 4 + 3 < i) a3 -= av[3] * X[j4 * 4 + 3];
                }
                X[i] = (a0 + a1) + (a2 + a3);
            }
            if (c < 128) {
                float* up = Ug + (size_t)it * 8192; const int slice = c >> 4, nn = c & 15;
#pragma unroll
                for (int mt = 0; mt < 4; ++mt)
#pragma unroll
                    for (int qq = 0; qq < 4; ++qq) { const int i0 = mt * 16 + qq * 4;
                        *(f32x4*)(up + ((slice * 4 + mt) * 64 + qq * 16 + nn) * 4) = (f32x4){X[i0], X[i0 + 1], X[i0 + 2], X[i0 + 3]}; }
            } else {
                bf16_t* wp = Wg + (size_t)it * 8192 + (c - 128);
#pragma unroll
                for (int i = 0; i < 64; ++i) wp[i * 128] = f2bf(X[i]);
            }
        }
        __syncthreads();
    }
}

__device__ __forceinline__ void dn_scan_chain(LAS unsigned char* lds, int lj, int chain) {
    const Params p = load_params();
    const int tid = tid_fresh(), w = __builtin_amdgcn_readfirstlane(tid >> 6), lane = tid & 63, fr = lane & 15, fq = lane >> 4;
    const int b = chain >> 2, h = chain & 3;
    bf16_t* proj = (bf16_t*)(p.ws + S_PROJ);
    const bf16_t* QGg = (const bf16_t*)(p.ws + S_QG); const bf16_t* KTg = (const bf16_t*)(p.ws + S_KT); const bf16_t* Wg = (const bf16_t*)(p.ws + S_W); const bf16_t* QKg = (const bf16_t*)(p.ws + S_QK);
    const float* GLg = (const float*)(p.ws + S_GL); const float* Ug = p.out;
    LAS float* SSQ = (LAS float*)(lds + 124928);
    const float nw = p.hyb_norm_w[lj * 128 + 16 * w + fr];
    f32x4 S[8];
#pragma unroll
    for (int i = 0; i < 8; ++i) S[i] = (f32x4){0.f, 0.f, 0.f, 0.f};
    u32x4 st[7]; f32x4 unext[4];
#define DN_ISSUE(it_) do { const size_t _it = (size_t)(it_); \
        const u32x4* gW = (const u32x4*)(Wg + _it * 8192); const u32x4* gQ = (const u32x4*)(QGg + _it * 8192); const u32x4* gK = (const u32x4*)(KTg + _it * 8192); const u32x4* gP = (const u32x4*)(QKg + _it * 4096); \
        st[0] = gW[tid]; st[1] = gW[tid + 512]; st[2] = gQ[tid]; st[3] = gQ[tid + 512]; st[4] = gK[tid]; st[5] = gK[tid + 512]; st[6] = gP[tid]; \
        _Pragma("unroll") for (int mt = 0; mt < 4; ++mt) unext[mt] = *(const f32x4*)(Ug + _it * 8192 + ((w * 4 + mt) * 64 + lane) * 4); } while (0)
#define DN_WRITE(bufb) do { LAS unsigned char* _b = lds + (bufb); \
        _Pragma("unroll") for (int i = 0; i < 2; ++i) { const int q = tid + 512 * i; \
            *(LAS u32x4*)(_b + (q >> 4) * 272 + (q & 15) * 16) = st[i]; \
            *(LAS u32x4*)(_b + 17408 + (q >> 4) * 272 + (q & 15) * 16) = st[2 + i]; \
            *(LAS u32x4*)(_b + 34816 + (q >> 3) * 144 + (q & 7) * 16) = st[4 + i]; } \
        *(LAS u32x4*)(_b + 53248 + (tid >> 3) * 144 + (tid & 7) * 16) = st[6]; } while (0)
    DN_ISSUE(chain * 64);
    DN_WRITE(0);
    __syncthreads();
    for (int n = 0; n < 64; ++n) {
        const int it = chain * 64 + n;
        f32x4 ucur[4];
#pragma unroll
        for (int mt = 0; mt < 4; ++mt) ucur[mt] = unext[mt];
        const float eg = __expf(GLg[it]);
        if (n < 63) DN_ISSUE(it + 1);
        bf16_t zv[4][4];
        const int rowb = b * SEQ + n * 64, colz = 2304 + h * 128 + 16 * w + fr;
#pragma unroll
        for (int mt = 0; mt < 4; ++mt)
#pragma unroll
            for (int e = 0; e < 4; ++e) zv[mt][e] = proj[(size_t)(rowb + 16 * mt + 4 * fq + e) * HPP + colz];
        LAS unsigned char* bb = lds + (n & 1) * 62464;
        bf16x8 Sb[4];
#pragma unroll
        for (int ks = 0; ks < 4; ++ks) Sb[ks] = pack8(S[2 * ks], S[2 * ks + 1]);
        f32x4 vn[4], oa[4];
#pragma unroll
        for (int mt = 0; mt < 4; ++mt) {
            f32x4 a1 = (f32x4){0.f, 0.f, 0.f, 0.f}, a2 = (f32x4){0.f, 0.f, 0.f, 0.f};
#pragma unroll
            for (int ks = 0; ks < 4; ++ks) {
                a1 = MFMA16(ldA_split(bb, 16 * mt + fr, 32 * ks + 4 * fq, 272), Sb[ks], a1);
                a2 = MFMA16(ldA_split(bb + 17408, 16 * mt + fr, 32 * ks + 4 * fq, 272), Sb[ks], a2);
            }
            vn[mt] = ucur[mt] - a1; oa[mt] = a2;
        }
        bf16x8 Vb[2];
        Vb[0] = pack8(vn[0], vn[1]); Vb[1] = pack8(vn[2], vn[3]);
#pragma unroll
        for (int mt = 0; mt < 4; ++mt)
#pragma unroll
            for (int k2 = 0; k2 < 2; ++k2) oa[mt] = MFMA16(ldA_split(bb + 53248, 16 * mt + fr, 32 * k2 + 4 * fq, 144), Vb[k2], oa[mt]);
#pragma unroll
        for (int dt = 0; dt < 8; ++dt) {
            S[dt] = S[dt] * eg;
#pragma unroll
            for (int k2 = 0; k2 < 2; ++k2) S[dt] = MFMA16(ldA_split(bb + 34816, 16 * dt + fr, 32 * k2 + 4 * fq, 144), Vb[k2], S[dt]);
        }
#pragma unroll
        for (int mt = 0; mt < 4; ++mt)
#pragma unroll
            for (int e = 0; e < 4; ++e) { float s = oa[mt][e] * oa[mt][e];
                s += __shfl_xor(s, 1); s += __shfl_xor(s, 2); s += __shfl_xor(s, 4); s += __shfl_xor(s, 8);
                if (fr == 0) SSQ[(n & 1) * 512 + (16 * mt + 4 * fq + e) * 8 + w] = s; }
        if (n < 63) DN_WRITE(((n + 1) & 1) * 62464);
        __syncthreads();
#pragma unroll
        for (int mt = 0; mt < 4; ++mt)
#pragma unroll
            for (int e = 0; e < 4; ++e) { const int tok = 16 * mt + 4 * fq + e;
                const f32x4 s0 = *(LAS f32x4*)(SSQ + (n & 1) * 512 + tok * 8), s1 = *(LAS f32x4*)(SSQ + (n & 1) * 512 + tok * 8 + 4);
                const float tot = ((s0[0] + s0[1]) + (s0[2] + s0[3])) + ((s1[0] + s1[1]) + (s1[2] + s1[3]));
                const float rstd = rsqrtf(tot * (1.0f / 128.0f) + 1e-6f); const float z = bf2f(zv[mt][e]);
                proj[(size_t)(rowb + tok) * HPP + colz] = f2bf(oa[mt][e] * rstd * nw * (z * sigmoidf_(z))); }
    }
#undef DN_ISSUE
#undef DN_WRITE
}

__device__ __forceinline__ void attn_items(LAS unsigned char* lds, int lj, int ab, int nab) {
    const Params p = load_params();
    const int tid = tid_fresh(), w = __builtin_amdgcn_readfirstlane(tid >> 6), lane = tid & 63, fr = lane & 15, fq = lane >> 4;
    bf16_t* proj = (bf16_t*)(p.ws + S_PROJ); const float* rope = (const float*)(p.ws + OFF_ROPE);
    LAS unsigned char* KS = lds; LAS unsigned char* VT = lds + 36864;
    for (int item = ab; item < 512; item += nab) {
        const int kvh = item & 1, nb = (item >> 1) & 31, b = item >> 6;
        {
            const int kb = tid >> 1, hf = tid & 1, pos = (nb - 1) * 128 + kb;
            u32x4 o1a = (u32x4){0u, 0u, 0u, 0u}, o1b = o1a, o2a = o1a, o2b = o1a;
            if (pos >= 0) {
                const bf16_t* kp = proj + (size_t)(b * SEQ + pos) * HPP + 512 + kvh * 64 + 16 * hf;
                const u32x4 x1a = *(const u32x4*)kp, x1b = *(const u32x4*)(kp + 8), x2a = *(const u32x4*)(kp + 32), x2b = *(const u32x4*)(kp + 40);
                const float x1[16] = {bflo(x1a.x), bfhi(x1a.x), bflo(x1a.y), bfhi(x1a.y), bflo(x1a.z), bfhi(x1a.z), bflo(x1a.w), bfhi(x1a.w), bflo(x1b.x), bfhi(x1b.x), bflo(x1b.y), bfhi(x1b.y), bflo(x1b.z), bfhi(x1b.z), bflo(x1b.w), bfhi(x1b.w)};
                const float x2[16] = {bflo(x2a.x), bfhi(x2a.x), bflo(x2a.y), bfhi(x2a.y), bflo(x2a.z), bfhi(x2a.z), bflo(x2a.w), bfhi(x2a.w), bflo(x2b.x), bfhi(x2b.x), bflo(x2b.y), bfhi(x2b.y), bflo(x2b.z), bfhi(x2b.z), bflo(x2b.w), bfhi(x2b.w)};
                const float* rp = rope + ((size_t)pos * 32 + 16 * hf) * 2;
                float r1[16], r2[16];
#pragma unroll
                for (int d2 = 0; d2 < 8; ++d2) { const f32x4 cs = *(const f32x4*)(rp + d2 * 4);
                    r1[2 * d2] = x1[2 * d2] * cs[0] - x2[2 * d2] * cs[1]; r2[2 * d2] = x2[2 * d2] * cs[0] + x1[2 * d2] * cs[1];
                    r1[2 * d2 + 1] = x1[2 * d2 + 1] * cs[2] - x2[2 * d2 + 1] * cs[3]; r2[2 * d2 + 1] = x2[2 * d2 + 1] * cs[2] + x1[2 * d2 + 1] * cs[3]; }
                o1a.x = cvt_pk_bf16(r1[0], r1[1]); o1a.y = cvt_pk_bf16(r1[2], r1[3]); o1a.z = cvt_pk_bf16(r1[4], r1[5]); o1a.w = cvt_pk_bf16(r1[6], r1[7]);
                o1b.x = cvt_pk_bf16(r1[8], r1[9]); o1b.y = cvt_pk_bf16(r1[10], r1[11]); o1b.z = cvt_pk_bf16(r1[12], r1[13]); o1b.w = cvt_pk_bf16(r1[14], r1[15]);
                o2a.x = cvt_pk_bf16(r2[0], r2[1]); o2a.y = cvt_pk_bf16(r2[2], r2[3]); o2a.z = cvt_pk_bf16(r2[4], r2[5]); o2a.w = cvt_pk_bf16(r2[6], r2[7]);
                o2b.x = cvt_pk_bf16(r2[8], r2[9]); o2b.y = cvt_pk_bf16(r2[10], r2[11]); o2b.z = cvt_pk_bf16(r2[12], r2[13]); o2b.w = cvt_pk_bf16(r2[14], r2[15]);
            }
            LAS unsigned char* kd = KS + kb * 144 + hf * 32;
            *(LAS u32x4*)kd = o1a; *(LAS u32x4*)(kd + 16) = o1b; *(LAS u32x4*)(kd + 64) = o2a; *(LAS u32x4*)(kd + 80) = o2b;
        }
        {
#pragma unroll
            for (int i = 0; i < 4; ++i) { const int q = tid + 512 * i, key = q >> 3, dc = q & 7, pos = (nb - 1) * 128 + key;
                u32x4 v = (u32x4){0u, 0u, 0u, 0u};
                if (pos >= 0) v = *(const u32x4*)(proj + (size_t)(b * SEQ + pos) * HPP + 640 + kvh * 64 + 8 * dc);
                LAS bf16_t* vd = (LAS bf16_t*)VT + (8 * dc) * 280 + key;
                vd[0] = (bf16_t)(v.x & 0xffffu); vd[280] = (bf16_t)(v.x >> 16); vd[2 * 280] = (bf16_t)(v.y & 0xffffu); vd[3 * 280] = (bf16_t)(v.y >> 16);
                vd[4 * 280] = (bf16_t)(v.z & 0xffffu); vd[5 * 280] = (bf16_t)(v.z >> 16); vd[6 * 280] = (bf16_t)(v.w & 0xffffu); vd[7 * 280] = (bf16_t)(v.w >> 16); }
            if (tid < 128) *(LAS u32x4*)(VT + (tid >> 1) * 560 + 512 + (tid & 1) * 16) = (u32x4){0u, 0u, 0u, 0u};
        }
        __syncthreads();
        const int qi = 16 * w + fr, pos_q = nb * 128 + qi, rowq = b * SEQ + pos_q;
        const int dl = fr - 4 * fq;
#pragma unroll 1
        for (int g = 0; g < 4; ++g) {
            const int head = kvh * 4 + g;
            bf16x8 Qf[2];
            { const bf16_t* qp = proj + (size_t)rowq * HPP + head * 64 + 8 * fq;
              const u32x4 xa = *(const u32x4*)qp, xb = *(const u32x4*)(qp + 32);
              const float x1[8] = {bflo(xa.x), bfhi(xa.x), bflo(xa.y), bfhi(xa.y), bflo(xa.z), bfhi(xa.z), bflo(xa.w), bfhi(xa.w)};
              const float x2[8] = {bflo(xb.x), bfhi(xb.x), bflo(xb.y), bfhi(xb.y), bflo(xb.z), bfhi(xb.z), bflo(xb.w), bfhi(xb.w)};
              const float* rp = rope + ((size_t)pos_q * 32 + 8 * fq) * 2;
              float r1[8], r2[8];
#pragma unroll
              for (int d2 = 0; d2 < 4; ++d2) { const f32x4 cs = *(const f32x4*)(rp + d2 * 4);
                  r1[2 * d2] = (x1[2 * d2] * cs[0] - x2[2 * d2] * cs[1]) * 0.125f; r2[2 * d2] = (x2[2 * d2] * cs[0] + x1[2 * d2] * cs[1]) * 0.125f;
                  r1[2 * d2 + 1] = (x1[2 * d2 + 1] * cs[2] - x2[2 * d2 + 1] * cs[3]) * 0.125f; r2[2 * d2 + 1] = (x2[2 * d2 + 1] * cs[2] + x1[2 * d2 + 1] * cs[3]) * 0.125f; }
              u32x4 a, c; a.x = cvt_pk_bf16(r1[0], r1[1]); a.y = cvt_pk_bf16(r1[2], r1[3]); a.z = cvt_pk_bf16(r1[4], r1[5]); a.w = cvt_pk_bf16(r1[6], r1[7]);
              c.x = cvt_pk_bf16(r2[0], r2[1]); c.y = cvt_pk_bf16(r2[2], r2[3]); c.z = cvt_pk_bf16(r2[4], r2[5]); c.w = cvt_pk_bf16(r2[6], r2[7]);
              Qf[0] = __builtin_bit_cast(bf16x8, a); Qf[1] = __builtin_bit_cast(bf16x8, c); }
            const float sink = p.hyb_sinks[lj * 8 + head];
            f32x4 sc[9];
            float mx = sink;
#pragma unroll
            for (int tt = 0; tt < 9; ++tt) {
                const int kt = w + tt;
                const bf16x8 k0 = *(LAS bf16x8*)(KS + (16 * kt + fr) * 144 + fq * 16), k1 = *(LAS bf16x8*)(KS + (16 * kt + fr) * 144 + 64 + fq * 16);
                f32x4 a = (f32x4){0.f, 0.f, 0.f, 0.f};
                a = MFMA16(k0, Qf[0], a); a = MFMA16(k1, Qf[1], a);
                const bool dead = (nb == 0) && (kt < 8);
#pragma unroll
                for (int e = 0; e < 4; ++e) { bool valid = !dead;
                    if (tt == 0) valid = valid && (e > dl);
                    if (tt == 8) valid = valid && (e <= dl);
                    a[e] = valid ? a[e] : -INFINITY; mx = fmaxf(mx, a[e]); }
                sc[tt] = a;
            }
            mx = fmaxf(mx, __shfl_xor(mx, 16)); mx = fmaxf(mx, __shfl_xor(mx, 32));
            float l = 0.f;
#pragma unroll
            for (int tt = 0; tt < 9; ++tt)
#pragma unroll
                for (int e = 0; e < 4; ++e) { const float pv = __expf(sc[tt][e] - mx); sc[tt][e] = pv; l += pv; }
            l += __shfl_xor(l, 16); l += __shfl_xor(l, 32);
            l += __expf(sink - mx);
            const float inv = 1.0f / l;
            f32x4 oacc[4];
#pragma unroll
            for (int mt = 0; mt < 4; ++mt) oacc[mt] = (f32x4){0.f, 0.f, 0.f, 0.f};
#pragma unroll
            for (int kk = 0; kk < 5; ++kk) {
                const bf16x8 Pb = pack8(sc[2 * kk], kk < 4 ? sc[2 * kk + 1] : (f32x4){0.f, 0.f, 0.f, 0.f});
                const int key0 = 16 * (w + 2 * kk) + 4 * fq;
#pragma unroll
                for (int mt = 0; mt < 4; ++mt) oacc[mt] = MFMA16(ldA_split(VT, 16 * mt + fr, key0, 560), Pb, oacc[mt]);
            }
            bf16_t* op = proj + (size_t)rowq * HPP + 1792 + head * 64 + 4 * fq;
#pragma unroll
            for (int mt = 0; mt < 4; ++mt) { u32x2 o; o.x = cvt_pk_bf16(oacc[mt][0] * inv, oacc[mt][1] * inv); o.y = cvt_pk_bf16(oacc[mt][2] * inv, oacc[mt][3] * inv); *(u32x2*)(op + 16 * mt) = o; }
        }
        __syncthreads();
    }
}

#define GSYNC() do { asm volatile("s_waitcnt vmcnt(0)" ::: "memory"); __syncthreads(); bar_epoch += 1u; \
        if (threadIdx.x == 0) { unsigned* cnt_ = (unsigned*)(load_params().ws + OFF_BAR); __builtin_amdgcn_fence(__ATOMIC_RELEASE, "agent"); asm volatile("s_waitcnt vmcnt(0)" ::: "memory"); \
            __hip_atomic_fetch_add(cnt_, 1u, __ATOMIC_RELAXED, __HIP_MEMORY_SCOPE_AGENT); const unsigned tgt_ = bar_epoch * gridDim.x; \
            while (__hip_atomic_load(cnt_, __ATOMIC_RELAXED, __HIP_MEMORY_SCOPE_AGENT) < tgt_) __builtin_amdgcn_s_sleep(1); } \
        __syncthreads(); __builtin_amdgcn_fence(__ATOMIC_ACQUIRE, "agent"); asm volatile("s_waitcnt vmcnt(0)" ::: "memory"); } while (0)
template <int layer>
__device__ __forceinline__ void layer_body(LAS unsigned char* lds, unsigned& bar_epoch, const int G, const int bid) {
        const int lj = layer >> 1;
        if ((layer & 1) == 0) {
            {
                const Params p = load_params();
                pg8::Gemm g{(const bf16_t*)(p.ws + OFF_XB), (const bf16_t*)(p.ws + WB_HIN) + (size_t)lj * 3072 * 1024, MTOK, 3072, 1024, 1024};
                pg8::Order S; S.init(MTOK, 3072, G, bid, 0);
                pg8::EpiProjHyb E{(bf16_t*)(p.ws + S_PROJ), (float*)(p.ws + S_BL)};
                pg8::gemm_phase(lds, g, S, E);
            }
            GSYNC();
            dn_local_phase(lds, lj);
            GSYNC();
            if (bid < 32) dn_scan_chain(lds, lj, bid);
            else attn_items(lds, lj, bid - 32, G - 32);
            GSYNC();
            {
                const Params p = load_params();
                pg8::Gemm g{(const bf16_t*)(p.ws + S_PROJ) + 1792, (const bf16_t*)(p.ws + WB_HOUT) + (size_t)lj * 1024 * 1024, MTOK, 1024, 1024, HPP};
                pg8::Order S; S.init(MTOK, 1024, G, bid, 0);
                pg8::EpiResid E{(const bf16_t*)(p.ws + OFF_XB), p.out};
                pg8::gemm_phase(lds, g, S, E);
            }
        } else {
            {
                const Params p = load_params();
                pg8::Gemm g{(const bf16_t*)(p.ws + OFF_XB), (const bf16_t*)(p.ws + WB_RIN) + (size_t)lj * 2048 * 1024, MTOK, 2048, 1024, 1024};
                pg8::Order S; S.init(MTOK, 2048, G, bid, 0);
                pg8::EpiBf16<0> E{(bf16_t*)(p.ws + S_PROJ2), 2048};
                pg8::gemm_phase(lds, g, S, E);
            }
            GSYNC();
            { const Params p = load_params();
              rconv_phase((const bf16_t*)(p.ws + S_PROJ2), p.rec_conv_w + (size_t)lj * 4 * 1024, p.rec_conv_b + lj * 1024, (bf16_t*)(p.ws + S_XRC)); }
            GSYNC();
            {
                const Params p = load_params();
                pg8::Gemm g{(const bf16_t*)(p.ws + S_XRC), (const bf16_t*)(p.ws + WB_RG) + (size_t)lj * 2048 * 256, MTOK, 2048, 256, 1024};
                pg8::Order S; S.init(MTOK, 2048, G, bid, 1);
                pg8::EpiBf16<0> E{(bf16_t*)(p.ws + S_LA), 2048};
                pg8::gemm_phase(lds, g, S, E);
            }
            GSYNC();
            { const Params p = load_params(); rscan_phase<1>((const bf16_t*)(p.ws + S_LA), (const bf16_t*)(p.ws + S_XRC), p.rec_b_a + lj * 1024, p.rec_b_x + lj * 1024, p.rec_lambda + lj * 1024, (float*)(p.ws + S_CLA), (float*)(p.ws + S_CH), (bf16_t*)(p.ws + S_PROJ2)); }
            GSYNC();
            { const Params p = load_params(); rscan_phase<2>((const bf16_t*)(p.ws + S_LA), (const bf16_t*)(p.ws + S_XRC), p.rec_b_a + lj * 1024, p.rec_b_x + lj * 1024, p.rec_lambda + lj * 1024, (float*)(p.ws + S_CLA), (float*)(p.ws + S_CH), (bf16_t*)(p.ws + S_PROJ2)); }
            GSYNC();
            {
                const Params p = load_params();
                pg8::Gemm g{(const bf16_t*)(p.ws + S_PROJ2), (const bf16_t*)(p.ws + WB_ROUT) + (size_t)lj * 1024 * 1024, MTOK, 1024, 1024, 2048};
                pg8::Order S; S.init(MTOK, 1024, G, bid, 0);
                pg8::EpiResid E{(const bf16_t*)(p.ws + OFF_XB), p.out};
                pg8::gemm_phase(lds, g, S, E);
            }
        }
        GSYNC();
        { const Params p = load_params(); ln_phase(p.out, p.ln1_g + layer * 1024, p.ln1_b + layer * 1024, (bf16_t*)(p.ws + OFF_XB), nullptr); }
        GSYNC();
        {
            const Params p = load_params();
            pg8::Gemm g{(const bf16_t*)(p.ws + OFF_XB), (const bf16_t*)(p.ws + WB_W1) + (size_t)layer * 4096 * 1024, MTOK, 4096, 1024, 1024};
            pg8::Order S; S.init(MTOK, 4096, G, bid, 0);
            pg8::EpiBf16<1> E{(bf16_t*)(p.ws + S_H), 4096};
            pg8::gemm_phase(lds, g, S, E);
        }
        GSYNC();
        {
            const Params p = load_params();
            pg8::Gemm g{(const bf16_t*)(p.ws + S_H), (const bf16_t*)(p.ws + WB_W2) + (size_t)layer * 1024 * 4096, MTOK, 1024, 4096, 4096};
            pg8::Order S; S.init(MTOK, 1024, G, bid, 0);
            pg8::EpiResid E{(const bf16_t*)(p.ws + OFF_XB), p.out};
            pg8::gemm_phase(lds, g, S, E);
        }
        GSYNC();
        { const Params p = load_params(); ln_phase(p.out, p.ln2_g + layer * 1024, p.ln2_b + layer * 1024, (bf16_t*)(p.ws + OFF_XB), layer == 3 ? p.out : nullptr); }
        if (layer < 3) GSYNC();
}

__global__ void __launch_bounds__(512) mega_fwd(Params p_unused) {
    extern __shared__ __attribute__((aligned(16))) unsigned char smem_raw[];
    LAS unsigned char* lds = (LAS unsigned char*)smem_raw;
    cg::grid_group grid = cg::this_grid();
    grid.sync();
    unsigned bar_epoch = 0;
    const int G = gridDim.x, bid = blockIdx.x;

    prep_phase(lds);
    GSYNC();

    layer_body<0>(lds, bar_epoch, G, bid);
    layer_body<1>(lds, bar_epoch, G, bid);
    layer_body<2>(lds, bar_epoch, G, bid);
    layer_body<3>(lds, bar_epoch, G, bid);
}

extern "C" void kernel_launch(void* const* d_in, const int* in_sizes, int n_in, void* d_out, int out_size, void* d_ws, size_t ws_size, hipStream_t stream) {
    static int grid = 0;
    if (grid == 0) {
        if (n_in != 23 || out_size != MTOK * DM || ws_size < WS_NEED) { fprintf(stderr, "kernel_launch: unexpected shapes (n_in %d, out %d, ws %zu)\n", n_in, out_size, ws_size); grid = -1; return; }
        int dev = 0, cus = 0, per_cu = 0;
        (void)hipGetDevice(&dev); (void)hipDeviceGetAttribute(&cus, hipDeviceAttributeMultiprocessorCount, dev);
        if (hipFuncSetAttribute((const void*)mega_fwd, hipFuncAttributeMaxDynamicSharedMemorySize, LDS_BYTES) != hipSuccess) { fprintf(stderr, "kernel_launch: hipFuncSetAttribute failed\n"); grid = -1; return; }
        (void)hipOccupancyMaxActiveBlocksPerMultiprocessor(&per_cu, (const void*)mega_fwd, 512, LDS_BYTES);
        if (per_cu < 1) { fprintf(stderr, "kernel_launch: occupancy query says 0\n"); per_cu = 1; }
        (void)hipGetLastError();
        grid = cus;
    }
    if (grid < 0) return;
    (void)hipMemsetAsync((char*)d_ws + OFF_BAR, 0, 256, stream);
    Params p{};
    const float** pp = (const float**)&p;
    for (int i = 0; i < 23; ++i) pp[i] = (const float*)d_in[i];
    p.out = (float*)d_out; p.ws = (unsigned char*)d_ws;
    void* args[] = {&p};
    hipError_t e = hipLaunchCooperativeKernel((const void*)mega_fwd, dim3(grid), dim3(512), args, LDS_BYTES, stream);
    if (e != hipSuccess) fprintf(stderr, "cooperative launch failed: %s (grid %d)\n", hipGetErrorString(e), grid);
}
```

```cpp
#include <hip/hip_runtime.h>
#include <hip/hip_cooperative_groups.h>
#include <cstdio>
#include <cstdint>
namespace cg = cooperative_groups;

#define LAS __attribute__((address_space(3)))
typedef unsigned short bf16_t;
typedef short bf16x8 __attribute__((ext_vector_type(8)));
typedef short bf16x4 __attribute__((ext_vector_type(4)));
typedef float f32x4 __attribute__((ext_vector_type(4)));
typedef float f32x2 __attribute__((ext_vector_type(2)));
typedef unsigned u32x4 __attribute__((ext_vector_type(4)));
typedef unsigned u32x2 __attribute__((ext_vector_type(2)));

constexpr int MTOK = 32768, DM = 1024, SEQ = 4096;
constexpr int HPP = 3072;
constexpr float DN_ALPHA = 1.6817928305074290f;
constexpr size_t MiB = 1024ull * 1024ull;
constexpr size_t WB_HIN = 0;
constexpr size_t WB_HOUT = WB_HIN + 2ull * 3072 * 1024 * 2;
constexpr size_t WB_RIN = WB_HOUT + 2ull * 1024 * 1024 * 2;
constexpr size_t WB_RG = WB_RIN + 2ull * 2048 * 1024 * 2;
constexpr size_t WB_ROUT = WB_RG + 2ull * 2048 * 256 * 2;
constexpr size_t WB_W1 = WB_ROUT + 2ull * 1024 * 1024 * 2;
constexpr size_t WB_W2 = WB_W1 + 4ull * 4096 * 1024 * 2;
constexpr size_t WB_END = WB_W2 + 4ull * 4096 * 1024 * 2;
static_assert(WB_END <= 96 * MiB, "weights");
constexpr size_t OFF_XB = 96 * MiB;
constexpr size_t OFF_ROPE = 160 * MiB;
constexpr size_t OFF_BAR = 161 * MiB;
constexpr size_t OFF_SCR = 162 * MiB;
constexpr size_t S_PROJ = OFF_SCR;
constexpr size_t S_BL = S_PROJ + 192 * MiB;
constexpr size_t S_QG = S_BL + 1 * MiB;
constexpr size_t S_KT = S_QG + 32 * MiB;
constexpr size_t S_W = S_KT + 32 * MiB;
constexpr size_t S_QK = S_W + 32 * MiB;
constexpr size_t S_GL = S_QK + 16 * MiB;
constexpr size_t S_PROJ2 = OFF_SCR;
constexpr size_t S_XRC = S_PROJ2 + 128 * MiB;
constexpr size_t S_LA = S_XRC + 64 * MiB;
constexpr size_t S_CLA = S_LA + 128 * MiB;
constexpr size_t S_CH = S_CLA + 2 * MiB;
constexpr size_t S_H = OFF_SCR;
constexpr size_t OFF_Y = 420 * MiB;
constexpr size_t WS_NEED = OFF_SCR + 326 * MiB;
constexpr int LDS_CTL = 157696;
constexpr int LDS_BYTES = LDS_CTL + 256;

struct Params {
    const float* x; const float* hyb_w_in; const float* hyb_sinks; const float* hyb_conv_w; const float* hyb_a_log; const float* hyb_dt_bias; const float* hyb_norm_w; const float* hyb_w_out;
    const float* rec_w_in; const float* rec_conv_w; const float* rec_conv_b; const float* rec_w_a; const float* rec_b_a; const float* rec_w_x; const float* rec_b_x; const float* rec_lambda; const float* rec_w_out;
    const float* ln1_g; const float* ln1_b; const float* mlp_w1; const float* mlp_w2; const float* ln2_g; const float* ln2_b;
    float* out; unsigned char* ws;
};

typedef const __attribute__((address_space(4))) Params* KParamsPtr;
__device__ __forceinline__ Params load_params() {
#if defined(__HIP_DEVICE_COMPILE__)
    KParamsPtr k = (KParamsPtr)__builtin_amdgcn_kernarg_segment_ptr(); asm volatile("" : "+s"(k));
    Params r; const __attribute__((address_space(4))) unsigned long long* q = (const __attribute__((address_space(4))) unsigned long long*)k; const char** d = (const char**)&r;
#pragma unroll
    for (int i = 0; i < (int)(sizeof(Params) / 8); ++i) { const __attribute__((address_space(1))) char* gp = (const __attribute__((address_space(1))) char*)q[i]; d[i] = (const char*)gp; }
    return r;
#else
    return Params{};
#endif
}
__device__ __forceinline__ int tid_fresh() { int t = threadIdx.x; asm volatile("" : "+v"(t)); return t; }
typedef __bf16 bf16x2_t __attribute__((ext_vector_type(2)));
__device__ __forceinline__ unsigned cvt_pk_bf16(float lo, float hi) { const f32x2 v = {lo, hi}; const bf16x2_t b = __builtin_convertvector(v, bf16x2_t); return __builtin_bit_cast(unsigned, b); }
__device__ __forceinline__ bf16_t f2bf(float f) { return (bf16_t)(cvt_pk_bf16(f, 0.f) & 0xffffu); }
__device__ __forceinline__ float bf2f(bf16_t b) { return __uint_as_float(((unsigned)b) << 16); }
__device__ __forceinline__ float bflo(unsigned u) { return __uint_as_float(u << 16); }
__device__ __forceinline__ float bfhi(unsigned u) { return __uint_as_float(u & 0xffff0000u); }
__device__ __forceinline__ float sigmoidf_(float x) { return 1.0f / (1.0f + __expf(-x)); }
__device__ __forceinline__ bf16x8 pack8(const f32x4 a, const f32x4 b) {
    u32x4 w; w.x = cvt_pk_bf16(a[0], a[1]); w.y = cvt_pk_bf16(a[2], a[3]); w.z = cvt_pk_bf16(b[0], b[1]); w.w = cvt_pk_bf16(b[2], b[3]);
    return __builtin_bit_cast(bf16x8, w);
}
__device__ __forceinline__ bf16x8 ldA_split(LAS unsigned char* base, int row, int col, int strideB) {
    const u32x2 lo = *(LAS u32x2*)(base + row * strideB + col * 2);
    const u32x2 hi = *(LAS u32x2*)(base + row * strideB + (col + 16) * 2);
    u32x4 w; w.x = lo.x; w.y = lo.y; w.z = hi.x; w.w = hi.y;
    return __builtin_bit_cast(bf16x8, w);
}
#define DPP_ADD(s, ctrl) ((s) + __builtin_bit_cast(float, __builtin_amdgcn_update_dpp(0, __builtin_bit_cast(int, (s)), (ctrl), 0xF, 0xF, true)))
__device__ __forceinline__ float row8_sum(float s) { s = DPP_ADD(s, 0xB1); s = DPP_ADD(s, 0x4E); s = DPP_ADD(s, 0x141); return s; }
__device__ __forceinline__ float row16_sum(float s) { s = row8_sum(s); s = DPP_ADD(s, 0x140); return s; }
__device__ __forceinline__ float wave64_sum(float s) { s = row16_sum(s);
    return (__builtin_bit_cast(float, __builtin_amdgcn_readlane(__builtin_bit_cast(int, s), 0)) + __builtin_bit_cast(float, __builtin_amdgcn_readlane(__builtin_bit_cast(int, s), 16)))
         + (__builtin_bit_cast(float, __builtin_amdgcn_readlane(__builtin_bit_cast(int, s), 32)) + __builtin_bit_cast(float, __builtin_amdgcn_readlane(__builtin_bit_cast(int, s), 48))); }
#define XB_TMO      128
#define XB_XCNT(j)  (256  + 64 * (j))
#define XB_XSUB(j)  (1280 + 64 * (j))
#define XB_XGEN(j)  (2304 + 64 * (j))
#define XB_TOP      3328
#define XB_TOPGEN   3392
#define XCD_BAR_WORDS 3456
#define XB_SPIN_CAP (1u << 22)
__device__ __forceinline__ unsigned xb_ld(unsigned* p)              { return __hip_atomic_load(p, __ATOMIC_RELAXED, __HIP_MEMORY_SCOPE_AGENT); }
__device__ __forceinline__ unsigned xb_add(unsigned* p, unsigned v) { return __hip_atomic_fetch_add(p, v, __ATOMIC_RELAXED, __HIP_MEMORY_SCOPE_AGENT); }
__device__ __forceinline__ unsigned xb_xcc_id() { return (unsigned)__builtin_amdgcn_s_getreg((3 << 11) | 20) & 0xFu; }
#define XB_SPIN(cond, bar) do { unsigned _sp = 0; while (cond) { __builtin_amdgcn_s_sleep(1); \
    if ((++_sp & 255u) == 0u) { if (xb_ld(&(bar)[XB_TMO])) break; if (_sp > XB_SPIN_CAP) { atomicAdd(&(bar)[XB_TMO], 1u); break; } } } } while (0)
__device__ __forceinline__ void xcd_barrier_complete(unsigned* bar, unsigned x, unsigned& nloc, unsigned& nx) {
    const unsigned G = gridDim.x;
    unsigned sum, cnt, mine, sp = 0u;
    for (;;) {
        sum = 0u; cnt = 0u; mine = 0u;
#pragma unroll
        for (unsigned j = 0; j < 16; ++j) { const unsigned c = xb_ld(&bar[XB_XCNT(j)]); sum += c; cnt += (c > 0u) ? 1u : 0u; mine = (j == x) ? c : mine; }
        if (sum == G) break;
        __builtin_amdgcn_s_sleep(1);
        if ((++sp & 255u) == 0u) { if (xb_ld(&bar[XB_TMO])) break; if (sp > XB_SPIN_CAP) { atomicAdd(&bar[XB_TMO], 1u); break; } }
    }
    nloc = mine > 0u ? mine : 1u; nx = cnt > 0u ? cnt : 1u;
}
__device__ __forceinline__ void xcd_barrier(unsigned* bar, const unsigned x, volatile LAS unsigned* st) {
    asm volatile("s_waitcnt vmcnt(0)" ::: "memory");
    __syncthreads();
    if (threadIdx.x == 0) {
        __builtin_amdgcn_s_waitcnt(0);
        unsigned nloc = st[0], nx = st[1];
        if (nloc == 0u) { xcd_barrier_complete(bar, x, nloc, nx); st[0] = nloc; st[1] = nx; }
        const unsigned old = xb_add(&bar[XB_XSUB(x)], 1u);
        const unsigned gen = old / nloc;
        if (old + 1u == (gen + 1u) * nloc) {
            __builtin_amdgcn_fence(__ATOMIC_RELEASE, "agent");
            asm volatile("s_waitcnt vmcnt(0)" ::: "memory");
            const unsigned og = xb_add(&bar[XB_TOP], 1u);
            const unsigned tg = og / nx;
            if (og + 1u == (tg + 1u) * nx) xb_add(&bar[XB_TOPGEN], 1u);
            else XB_SPIN(xb_ld(&bar[XB_TOPGEN]) == tg, bar);
            __builtin_amdgcn_fence(__ATOMIC_ACQUIRE, "agent");
            xb_add(&bar[XB_XGEN(x)], 1u);
            asm volatile("s_waitcnt vmcnt(0)" ::: "memory");
        } else {
            XB_SPIN(xb_ld(&bar[XB_XGEN(x)]) == gen, bar);
            __builtin_amdgcn_fence(__ATOMIC_ACQUIRE, "agent");
            asm volatile("s_waitcnt vmcnt(0)" ::: "memory");
        }
    }
    __syncthreads();
}
#ifdef TS_SELECT
__device__ __forceinline__ void ts_mark(LAS unsigned char* lds, int cls) {
    if (blockIdx.x == TS_BLOCK && threadIdx.x == 0) { LAS unsigned* tw = (LAS unsigned*)(lds + LDS_CTL); const unsigned now = (unsigned)__builtin_amdgcn_s_memrealtime();
        tw[2 + cls] += now - tw[0]; tw[0] = now; }
}
#define PHC(c) ph_cls = (c)
#define TSM(c) ts_mark(lds, (c) >= 8 ? 7 : (c))
#else
#define PHC(c)
#define TSM(c)
#endif
#define MFMA16(a, b, c) __builtin_amdgcn_mfma_f32_16x16x32_bf16((a), (b), (c), 0, 0, 0)

namespace pg8 {
constexpr int BM = 256, BK = 64, HALF = 128, HTB = HALF * BK * 2, STAGE_BYTES = 8 * HTB, NXCD = 8, WGM = 8;
__host__ __device__ __forceinline__ int lds_byte(int r, int c) { const int st = (r >> 4) * 2 + (c >> 5), rr = r & 15, cc = c & 31, ob = rr * 64 + cc * 2; return st * 1024 + (ob ^ (((ob >> 9) & 1) << 5)); }
__host__ __device__ __forceinline__ void stage_rc(int b, int& R, int& C) { const int st = b / 1024, sb = b % 1024, swz = sb ^ (((sb >> 9) & 1) << 5); R = (st >> 1) * 16 + swz / 64; C = (st & 1) * 32 + (swz % 64) / 2; }
__host__ __device__ __forceinline__ int perm32(int rho) { const int n = rho >> 4, i = rho & 15; return 8 * (i >> 2) + 4 * n + (i & 3); }

struct Unit { int pm, pn, ka; };
struct Gemm { const bf16_t* A; const bf16_t* Bt; int M, N, K, lda; };

struct Order {
    int nM, nN, nwg, G, c, gates;
    __device__ void init(int M, int N, int G_, int c_, int gates_) { nM = M / BM; nN = N / BM; nwg = nM * nN; G = G_; c = c_; gates = gates_; }
    __device__ bool next(int i, Unit& u) const {
        const long L = (long)i * G + c; if (L >= nwg) return false;
        int wgid = (int)L; { const int q = nwg / NXCD, r = nwg % NXCD, xcd = wgid % NXCD, off = wgid / NXCD; wgid = (xcd < r ? xcd * (q + 1) : r * (q + 1) + (xcd - r) * q) + off; }
        const int nig = WGM * nN, gid = wgid / nig, fm = gid * WGM, gsz = (nM - fm) < WGM ? (nM - fm) : WGM;
        u.pm = fm + ((wgid % nig) % gsz); u.pn = (wgid % nig) / gsz; u.ka = gates ? (u.pn >> 1) * 256 : 0; return true;
    }
};

template <class Epi>
__device__ __forceinline__ void gemm_phase(LAS unsigned char* lds, const Gemm g, const Order& S, const Epi& E) {
    const int tid = tid_fresh(), wid = __builtin_amdgcn_readfirstlane(tid >> 6), lane = tid & 63, wr = wid >> 2, wc = wid & 3, fr = lane & 15, fq = lane >> 4;
    const int K = g.K, nt = K / BK;
    unsigned voffA[2], voffB[2];
#pragma unroll
    for (int i = 0; i < 2; ++i) { int R, C; stage_rc(tid * 16 + i * 8192, R, C); const int Rb = Epi::PERM ? ((R & ~31) + perm32(R & 31)) : R;
        voffA[i] = (unsigned)(R * g.lda + C) * 2u; voffB[i] = (unsigned)(Rb * K + C) * 2u; }
    const size_t kstep = (size_t)(BK * 2);
    const size_t hstepA = (size_t)HALF * g.lda * 2, hstepB = (size_t)HALF * K * 2;
    const size_t tstepA = 2 * hstepA, tstepB = 2 * hstepB;
    const unsigned ldsw = (unsigned)wid * 1024u;
    const int aoff = lds_byte(wr * 64 + fr, fq * 8), boff = lds_byte(wc * 32 + fr, fq * 8);
#define PG8_SA(b, h) (((b) * 2 + (h)) * HTB)
#define PG8_SB(b, h) ((4 + (b) * 2 + (h)) * HTB)
#define PG8_STAGE(bufoff, gbase, voff) do { _Pragma("unroll") for (int _i = 0; _i < 2; ++_i) \
        __builtin_amdgcn_global_load_lds((const unsigned*)((const char*)(gbase) + (voff)[_i]), (LAS unsigned*)(lds + (bufoff) + ldsw + _i * 8192), 16, 0, 0); } while (0)
#define PG8_LDA(dst, b, h) do { _Pragma("unroll") for (int m = 0; m < 4; ++m) _Pragma("unroll") for (int k = 0; k < 2; ++k) dst[m][k] = *(const LAS bf16x8*)(lds + PG8_SA(b, h) + aoff + m * 2048 + k * 1024); } while (0)
#define PG8_LDB(dst, b, h) do { _Pragma("unroll") for (int n = 0; n < 2; ++n) _Pragma("unroll") for (int k = 0; k < 2; ++k) dst[n][k] = *(const LAS bf16x8*)(lds + PG8_SB(b, h) + boff + n * 2048 + k * 1024); } while (0)
#define PG8_MMA(ai, bj, At, Bt) do { __builtin_amdgcn_s_setprio(1); _Pragma("unroll") for (int m = 0; m < 4; ++m) _Pragma("unroll") for (int n = 0; n < 2; ++n) _Pragma("unroll") for (int k = 0; k < 2; ++k) \
        acc[ai][bj][m][n] = __builtin_amdgcn_mfma_f32_16x16x32_bf16(Bt[n][k], At[m][k], acc[ai][bj][m][n], 0, 0, 0); __builtin_amdgcn_s_setprio(0); } while (0)
#define PG8_WAIT_V(n) asm volatile("s_waitcnt vmcnt(" #n ")" ::: "memory")
#define PG8_WAIT_L(n) asm volatile("s_waitcnt lgkmcnt(" #n ")" ::: "memory")
#define PG8_BAR __builtin_amdgcn_s_barrier()
#define PG8_SCHED __builtin_amdgcn_sched_barrier(0)
    Unit cur, nxt; int ui = 0;
    if (!S.next(0, cur)) return;
    f32x4 acc[2][2][4][2];
#pragma unroll
    for (int a = 0; a < 2; ++a)
#pragma unroll
        for (int b = 0; b < 2; ++b)
#pragma unroll
            for (int m = 0; m < 4; ++m)
#pragma unroll
                for (int n = 0; n < 2; ++n) acc[a][b][m][n] = (f32x4){0.f, 0.f, 0.f, 0.f};
    bf16x8 At[4][2], B0[2][2], B1[2][2];
    const char* cA = (const char*)g.A + (size_t)cur.pm * tstepA + (size_t)cur.ka * 2; const char* cB = (const char*)g.Bt + (size_t)cur.pn * tstepB;
    PG8_STAGE(PG8_SB(0, 0), cB, voffB); PG8_STAGE(PG8_SA(0, 0), cA, voffA); PG8_STAGE(PG8_SB(0, 1), cB + hstepB, voffB); PG8_STAGE(PG8_SA(0, 1), cA + hstepA, voffA);
    if (wr == 1) PG8_BAR;
    PG8_WAIT_V(4); PG8_BAR;
    PG8_STAGE(PG8_SB(1, 0), cB + kstep, voffB); PG8_STAGE(PG8_SA(1, 0), cA + kstep, voffA); PG8_STAGE(PG8_SB(1, 1), cB + hstepB + kstep, voffB);
    PG8_WAIT_V(6); PG8_BAR;
    for (;;) {
        const bool has_next = S.next(ui + 1, nxt);
        const char* nA = has_next ? (const char*)g.A + (size_t)nxt.pm * tstepA + (size_t)nxt.ka * 2 : cA; const char* nB = has_next ? (const char*)g.Bt + (size_t)nxt.pn * tstepB : cB;
        for (int t = 0; t < nt; t += 2) {
            const bool last = (t == nt - 2);
            const char* a1 = cA + (size_t)(t + 1) * kstep;
            const char* a2 = last ? nA : cA + (size_t)(t + 2) * kstep; const char* b2 = last ? nB : cB + (size_t)(t + 2) * kstep;
            const char* a3 = a2 + kstep; const char* b3 = b2 + kstep;
            PG8_LDB(B0, 0, 0); PG8_SCHED; PG8_LDA(At, 0, 0); PG8_STAGE(PG8_SA(1, 1), a1 + hstepA, voffA);
            PG8_WAIT_L(8); PG8_BAR; PG8_WAIT_L(0); PG8_MMA(0, 0, At, B0); PG8_BAR; PG8_SCHED;
            PG8_LDB(B1, 0, 1); PG8_STAGE(PG8_SB(0, 0), b2, voffB);
            PG8_BAR; PG8_WAIT_L(0); PG8_MMA(0, 1, At, B1); PG8_BAR;
            PG8_LDA(At, 0, 1); PG8_STAGE(PG8_SA(0, 0), a2, voffA);
            PG8_BAR; PG8_WAIT_L(0); PG8_MMA(1, 0, At, B0); PG8_BAR; PG8_SCHED;
            PG8_STAGE(PG8_SB(0, 1), b2 + hstepB, voffB);
            PG8_WAIT_V(6); PG8_BAR; PG8_MMA(1, 1, At, B1); PG8_BAR;
            PG8_LDB(B0, 1, 0); PG8_SCHED; PG8_LDA(At, 1, 0); PG8_STAGE(PG8_SA(0, 1), a2 + hstepA, voffA);
            PG8_WAIT_L(8); PG8_BAR; PG8_WAIT_L(0); PG8_MMA(0, 0, At, B0); PG8_BAR; PG8_SCHED;
            PG8_LDB(B1, 1, 1); PG8_STAGE(PG8_SB(1, 0), b3, voffB);
            PG8_BAR; PG8_WAIT_L(0); PG8_MMA(0, 1, At, B1); PG8_BAR;
            PG8_LDA(At, 1, 1); PG8_STAGE(PG8_SA(1, 0), a3, voffA);
            PG8_BAR; PG8_WAIT_L(0); PG8_MMA(1, 0, At, B0); PG8_BAR; PG8_SCHED;
            PG8_STAGE(PG8_SB(1, 1), b3 + hstepB, voffB);
            PG8_WAIT_V(6); PG8_BAR; PG8_MMA(1, 1, At, B1); PG8_BAR;
        }
        E(acc, cur, wr, wc, fr, fq);
        if (!has_next) break;
#pragma unroll
        for (int a = 0; a < 2; ++a)
#pragma unroll
            for (int b = 0; b < 2; ++b)
#pragma unroll
                for (int m = 0; m < 4; ++m)
#pragma unroll
                    for (int n = 0; n < 2; ++n) acc[a][b][m][n] = (f32x4){0.f, 0.f, 0.f, 0.f};
        cur = nxt; cA = nA; cB = nB; ++ui;
    }
    PG8_WAIT_V(0);
    if (wr == 0) PG8_BAR;
    PG8_BAR;
#undef PG8_SA
#undef PG8_SB
#undef PG8_STAGE
#undef PG8_LDA
#undef PG8_LDB
#undef PG8_MMA
#undef PG8_WAIT_V
#undef PG8_WAIT_L
#undef PG8_BAR
#undef PG8_SCHED
}

typedef const f32x4 (&AccRef)[2][2][4][2];
template <int ACT> struct EpiBf16 {
    static constexpr bool PERM = true;
    bf16_t* O; int ldc;
    __device__ __forceinline__ void operator()(AccRef acc, const Unit& u, int wr, int wc, int fr, int fq) const {
        const int row0 = u.pm * BM + wr * 64 + fr, col0 = u.pn * BM + wc * 32 + 8 * fq;
#pragma unroll
        for (int ai = 0; ai < 2; ++ai)
#pragma unroll
            for (int m = 0; m < 4; ++m) { bf16_t* rowp = O + (size_t)(row0 + ai * HALF + m * 16) * ldc + col0;
#pragma unroll
                for (int bj = 0; bj < 2; ++bj) { f32x4 v0 = acc[ai][bj][m][0], v1 = acc[ai][bj][m][1];
                    if (ACT == 1) {
#pragma unroll
                        for (int j = 0; j < 4; ++j) { const float a = fmaxf(v0[j], 0.f), b = fmaxf(v1[j], 0.f); v0[j] = a * a; v1[j] = b * b; } }
                    u32x4 w; w.x = cvt_pk_bf16(v0[0], v0[1]); w.y = cvt_pk_bf16(v0[2], v0[3]); w.z = cvt_pk_bf16(v1[0], v1[1]); w.w = cvt_pk_bf16(v1[2], v1[3]);
                    *(u32x4*)(rowp + bj * HALF) = w; } }
    }
};
struct EpiProjHyb {
    static constexpr bool PERM = true;
    bf16_t* O; float* BL;
    __device__ __forceinline__ void operator()(AccRef acc, const Unit& u, int wr, int wc, int fr, int fq) const {
        const int row0 = u.pm * BM + wr * 64 + fr;
        if (u.pn == 11) {
            if (wc == 0 && fq == 0) {
#pragma unroll
                for (int ai = 0; ai < 2; ++ai)
#pragma unroll
                    for (int m = 0; m < 4; ++m) { float* bp = BL + (size_t)(row0 + ai * HALF + m * 16) * 8; *(f32x4*)bp = acc[ai][0][m][0]; *(f32x4*)(bp + 4) = acc[ai][0][m][1]; }
            }
            return;
        }
        const int col0 = u.pn * BM + wc * 32 + 8 * fq;
#pragma unroll
        for (int ai = 0; ai < 2; ++ai)
#pragma unroll
            for (int m = 0; m < 4; ++m) { bf16_t* rowp = O + (size_t)(row0 + ai * HALF + m * 16) * HPP + col0;
#pragma unroll
                for (int bj = 0; bj < 2; ++bj) { const f32x4 v0 = acc[ai][bj][m][0], v1 = acc[ai][bj][m][1];
                    u32x4 w; w.x = cvt_pk_bf16(v0[0], v0[1]); w.y = cvt_pk_bf16(v0[2], v0[3]); w.z = cvt_pk_bf16(v1[0], v1[1]); w.w = cvt_pk_bf16(v1[2], v1[3]);
                    *(u32x4*)(rowp + bj * HALF) = w; } }
    }
};
struct EpiResid {
    static constexpr bool PERM = true;
    const bf16_t* XB; bf16_t* Y;
    __device__ __forceinline__ void operator()(AccRef acc, const Unit& u, int wr, int wc, int fr, int fq) const {
        const int row0 = u.pm * BM + wr * 64 + fr, col0 = u.pn * BM + wc * 32 + 8 * fq;
#pragma unroll
        for (int ai = 0; ai < 2; ++ai)
#pragma unroll
            for (int m = 0; m < 4; ++m) { const size_t off = (size_t)(row0 + ai * HALF + m * 16) * DM + col0;
#pragma unroll
                for (int bj = 0; bj < 2; ++bj) { const size_t o = off + bj * HALF; const u32x4 xv = *(const u32x4*)(XB + o);
                    const f32x4 a0 = acc[ai][bj][m][0], a1 = acc[ai][bj][m][1];
                    u32x4 w;
                    w.x = cvt_pk_bf16(DN_ALPHA * bflo(xv.x) + a0[0], DN_ALPHA * bfhi(xv.x) + a0[1]); w.y = cvt_pk_bf16(DN_ALPHA * bflo(xv.y) + a0[2], DN_ALPHA * bfhi(xv.y) + a0[3]);
                    w.z = cvt_pk_bf16(DN_ALPHA * bflo(xv.z) + a1[0], DN_ALPHA * bfhi(xv.z) + a1[1]); w.w = cvt_pk_bf16(DN_ALPHA * bflo(xv.w) + a1[2], DN_ALPHA * bfhi(xv.w) + a1[3]);
                    *(u32x4*)(Y + o) = w; } }
    }
};
}

__device__ __forceinline__ void transpose_tile(const float* __restrict__ src, int ld, int K, int Nvalid, bf16_t* __restrict__ dst, int k0, int n0, LAS float* tile, const int tid) {
    { const int n = tid & 63, kk = tid >> 6;
#pragma unroll
      for (int i = 0; i < 8; ++i) { const int k = kk + 8 * i; tile[k * 65 + n] = (n0 + n < Nvalid) ? src[(size_t)(k0 + k) * ld + n0 + n] : 0.f; } }
    __syncthreads();
    { const int k2 = (tid & 31) * 2, nn = tid >> 5;
#pragma unroll
      for (int i = 0; i < 4; ++i) { const int n = nn + 16 * i; *(unsigned*)(dst + (size_t)(n0 + n) * K + k0 + k2) = cvt_pk_bf16(tile[k2 * 65 + n], tile[(k2 + 1) * 65 + n]); } }
    __syncthreads();
}

__device__ __forceinline__ void prep_phase(LAS unsigned char* lds) {
    const Params p = load_params();
    const int tid = tid_fresh(), G = gridDim.x;
    const size_t gtid = (size_t)blockIdx.x * 512 + tid, gsz = (size_t)G * 512;
    {
        const f32x4* src = (const f32x4*)p.x; u32x2* dst = (u32x2*)(p.ws + OFF_XB);
        const size_t n4 = (size_t)MTOK * DM / 4;
        for (size_t i = gtid; i < n4; i += 4 * gsz) {
            f32x4 v[4];
#pragma unroll
            for (int k = 0; k < 4; ++k) v[k] = (i + k * gsz < n4) ? src[i + k * gsz] : (f32x4){0.f, 0.f, 0.f, 0.f};
#pragma unroll
            for (int k = 0; k < 4; ++k) if (i + k * gsz < n4) { u32x2 w; w.x = cvt_pk_bf16(v[k][0], v[k][1]); w.y = cvt_pk_bf16(v[k][2], v[k][3]); dst[i + k * gsz] = w; }
        }
    }
    {
        float* rope = (float*)(p.ws + OFF_ROPE);
        for (size_t i = gtid; i < (size_t)SEQ * 32; i += gsz) { const int t = (int)(i >> 5), j = (int)(i & 31);
            const float inv = (float)exp(-(double)j * (9.210340371976184 / 32.0)); const float ang = (float)t * inv;
            double s, c; sincos((double)ang, &s, &c); rope[i * 2] = (float)c; rope[i * 2 + 1] = (float)s; }
    }
    LAS float* tile = (LAS float*)lds;
    int base = 0;
    for (int j = 0; j < 17; ++j) {
        const float* src = nullptr; bf16_t* dst = nullptr; int ld = 0, K = 0, N = 0, Np = 0, ntiles;
        if (j < 2) { src = p.hyb_w_in + (size_t)j * 1024 * 2824; ld = 2824; K = 1024; N = 2824; Np = 3072; dst = (bf16_t*)(p.ws + WB_HIN) + (size_t)j * 3072 * 1024; }
        else if (j < 4) { const int l = j - 2; src = p.hyb_w_out + (size_t)l * 1024 * 1024; ld = 1024; K = 1024; N = 1024; Np = 1024; dst = (bf16_t*)(p.ws + WB_HOUT) + (size_t)l * 1024 * 1024; }
        else if (j < 6) { const int l = j - 4; src = p.rec_w_in + (size_t)l * 1024 * 2048; ld = 2048; K = 1024; N = 2048; Np = 2048; dst = (bf16_t*)(p.ws + WB_RIN) + (size_t)l * 2048 * 1024; }
        else if (j < 8) { const int l = j - 6; src = p.rec_w_out + (size_t)l * 1024 * 1024; ld = 1024; K = 1024; N = 1024; Np = 1024; dst = (bf16_t*)(p.ws + WB_ROUT) + (size_t)l * 1024 * 1024; }
        else if (j < 12) { const int l = j - 8; src = p.mlp_w1 + (size_t)l * 1024 * 4096; ld = 4096; K = 1024; N = 4096; Np = 4096; dst = (bf16_t*)(p.ws + WB_W1) + (size_t)l * 4096 * 1024; }
        else if (j < 16) { const int l = j - 12; src = p.mlp_w2 + (size_t)l * 4096 * 1024; ld = 1024; K = 4096; N = 1024; Np = 1024; dst = (bf16_t*)(p.ws + WB_W2) + (size_t)l * 1024 * 4096; }
        ntiles = (j < 16) ? (K / 64) * (Np / 64) : 256;
        for (int t = ((int)blockIdx.x - base % G + G) % G; t < ntiles; t += G) {
            if (j < 16) { const int kt = t % (K / 64), ntl = t / (K / 64); transpose_tile(src, ld, K, N, dst, kt * 64, ntl * 64, tile, tid); }
            else {
                const int idx = t >> 3, sub = t & 7, kt = sub & 3, ntl = sub >> 2, l = idx >> 4, pn = (idx >> 1) & 7, gg = idx & 1, h = pn >> 1, hh = pn & 1;
                const float* s2 = (gg ? p.rec_w_x : p.rec_w_a) + (size_t)l * 4 * 65536 + (size_t)h * 65536 + hh * 128;
                bf16_t* d2 = (bf16_t*)(p.ws + WB_RG) + (size_t)l * 2048 * 256 + (size_t)(pn * 256 + gg * 128) * 256;
                transpose_tile(s2, 256, 256, 128, d2, kt * 64, ntl * 64, tile, tid);
            }
        }
        base += ntiles;
    }
}

__device__ __forceinline__ void ln_phase(const bf16_t* Y, const float* __restrict__ g, const float* __restrict__ b, bf16_t* xb, float* outf) {
    const int tid = tid_fresh(); const int wave = tid >> 6, lane = tid & 63;
    f32x4 gv[4], bv[4];
#pragma unroll
    for (int j = 0; j < 2; ++j) { gv[2 * j] = *(const f32x4*)(g + j * 512 + lane * 8); gv[2 * j + 1] = *(const f32x4*)(g + j * 512 + lane * 8 + 4);
        bv[2 * j] = *(const f32x4*)(b + j * 512 + lane * 8); bv[2 * j + 1] = *(const f32x4*)(b + j * 512 + lane * 8 + 4); }
    const int nw = gridDim.x * 8;
    for (int row0 = blockIdx.x * 8 + wave; row0 < MTOK; row0 += 4 * nw) {
        u32x4 raw[4][2];
#pragma unroll
        for (int r = 0; r < 4; ++r) { const bf16_t* yr = Y + (size_t)(row0 + r * nw) * DM;
#pragma unroll
            for (int j = 0; j < 2; ++j) raw[r][j] = *(const u32x4*)(yr + j * 512 + lane * 8); }
#pragma unroll
        for (int r = 0; r < 4; ++r) {
            const int row = row0 + r * nw;
            f32x4 v[4];
#pragma unroll
            for (int j = 0; j < 2; ++j) { const u32x4 q = raw[r][j]; v[2 * j] = (f32x4){bflo(q.x), bfhi(q.x), bflo(q.y), bfhi(q.y)}; v[2 * j + 1] = (f32x4){bflo(q.z), bfhi(q.z), bflo(q.w), bfhi(q.w)}; }
            float s = 0.f;
#pragma unroll
            for (int j = 0; j < 4; ++j) s += (v[j][0] + v[j][1]) + (v[j][2] + v[j][3]);
            s = wave64_sum(s);
            const float mean = s * (1.0f / 1024.0f);
            float q = 0.f;
#pragma unroll
            for (int j = 0; j < 4; ++j) { const f32x4 d = v[j] - mean; q += (d[0] * d[0] + d[1] * d[1]) + (d[2] * d[2] + d[3] * d[3]); }
            q = wave64_sum(q);
            const float rstd = rsqrtf(q * (1.0f / 1024.0f) + 1e-5f);
            f32x4 o[4];
#pragma unroll
            for (int j = 0; j < 4; ++j) o[j] = (v[j] - mean) * rstd * gv[j] + bv[j];
#pragma unroll
            for (int j = 0; j < 2; ++j) {
                if (outf) { float* op = outf + (size_t)row * DM + j * 512 + lane * 8; *(f32x4*)op = o[2 * j]; *(f32x4*)(op + 4) = o[2 * j + 1]; }
                else { u32x4 w; w.x = cvt_pk_bf16(o[2 * j][0], o[2 * j][1]); w.y = cvt_pk_bf16(o[2 * j][2], o[2 * j][3]); w.z = cvt_pk_bf16(o[2 * j + 1][0], o[2 * j + 1][1]); w.w = cvt_pk_bf16(o[2 * j + 1][2], o[2 * j + 1][3]);
                    *(u32x4*)(xb + (size_t)row * DM + j * 512 + lane * 8) = w; } }
        }
    }
}

__device__ __forceinline__ void rconv_phase(const bf16_t* proj2, const float* __restrict__ cw, const float* __restrict__ cb, bf16_t* xrc) {
    const int tid = tid_fresh();
    for (int it = blockIdx.x * 512 + tid; it < 131072; it += gridDim.x * 512) {
        const int cgp = it & 127, seg = (it >> 7) & 127, b = it >> 14, c0 = cgp * 8, t0 = seg * 32;
        float w[4][8], bias[8], xw[3][8];
#pragma unroll
        for (int j = 0; j < 4; ++j) { const f32x4 a = *(const f32x4*)(cw + j * 1024 + c0), c = *(const f32x4*)(cw + j * 1024 + c0 + 4);
#pragma unroll
            for (int d = 0; d < 4; ++d) { w[j][d] = a[d]; w[j][4 + d] = c[d]; } }
        { const f32x4 a = *(const f32x4*)(cb + c0), c = *(const f32x4*)(cb + c0 + 4);
#pragma unroll
          for (int d = 0; d < 4; ++d) { bias[d] = a[d]; bias[4 + d] = c[d]; } }
#pragma unroll
        for (int j = 0; j < 3; ++j) { const int t = t0 - 3 + j;
            u32x4 v = (u32x4){0u, 0u, 0u, 0u};
            if (t >= 0) v = *(const u32x4*)(proj2 + (size_t)(b * SEQ + t) * 2048 + c0);
            xw[j][0] = bflo(v.x); xw[j][1] = bfhi(v.x); xw[j][2] = bflo(v.y); xw[j][3] = bfhi(v.y); xw[j][4] = bflo(v.z); xw[j][5] = bfhi(v.z); xw[j][6] = bflo(v.w); xw[j][7] = bfhi(v.w); }
#pragma unroll 4
        for (int t = 0; t < 32; ++t) {
            const u32x4 v = *(const u32x4*)(proj2 + (size_t)(b * SEQ + t0 + t) * 2048 + c0);
            const float x3[8] = {bflo(v.x), bfhi(v.x), bflo(v.y), bfhi(v.y), bflo(v.z), bfhi(v.z), bflo(v.w), bfhi(v.w)};
            float y[8];
#pragma unroll
            for (int d = 0; d < 8; ++d) { y[d] = bias[d] + w[0][d] * xw[0][d] + w[1][d] * xw[1][d] + w[2][d] * xw[2][d] + w[3][d] * x3[d]; xw[0][d] = xw[1][d]; xw[1][d] = xw[2][d]; xw[2][d] = x3[d]; }
            u32x4 o; o.x = cvt_pk_bf16(y[0], y[1]); o.y = cvt_pk_bf16(y[2], y[3]); o.z = cvt_pk_bf16(y[4], y[5]); o.w = cvt_pk_bf16(y[6], y[7]);
            *(u32x4*)(xrc + (size_t)(b * SEQ + t0 + t) * DM + c0) = o;
        }
    }
}
__device__ __forceinline__ void lru_ab(float ra, float ix, float x, float sp, float& a, float& b, float& l) {
    const float r = sigmoidf_(ra), ig = sigmoidf_(ix); l = r * sp; const float x2 = 2.0f * l;
    a = __expf(l);
    const float om = (x2 > -0.25f) ? -x2 * (1.0f + x2 * (0.5f + x2 * (0.16666667f + x2 * (0.041666668f + x2 * (0.0083333333f + x2 * 0.0013888889f))))) : 1.0f - a * a;
    b = sqrtf(fmaxf(om, 0.f)) * (ig * x);
}
__device__ __forceinline__ float softplus_neg8(float lm) { const float e = __expf(-lm); const float l1 = (e < 0.03f) ? e * (1.0f - e * (0.5f - e * (0.33333333f - 0.25f * e))) : __logf(1.0f + e); return -8.0f * l1; }
__device__ __forceinline__ float gelu_tanh(float x) { const float u = 0.7978845608028654f * (x + 0.044715f * x * x * x); const float t = 1.0f - 2.0f / (1.0f + __expf(2.0f * u)); return 0.5f * x * (1.0f + t); }
template <int PASS>
__device__ __forceinline__ void rscan_phase(const bf16_t* GB, const bf16_t* xrc, const float* __restrict__ b_a, const float* __restrict__ b_x, const float* __restrict__ lam, float* CLA, float* CH, bf16_t* proj2, unsigned* LB) {
    const int tid = tid_fresh();
    for (int it = blockIdx.x * 512 + tid; it < 8 * 64 * 512; it += gridDim.x * 512) {
        const int cp = it & 511, seg = (it >> 9) & 63, b = it >> 15, c = 2 * cp, gcol = (c >> 7) * 256 + (c & 127);
        float h0 = 0.f, h1 = 0.f, sl0 = 0.f, sl1 = 0.f;
        const size_t row0 = (size_t)(b * SEQ + seg * 64);
        if (PASS == 1) {
            const float ba0 = b_a[c], ba1 = b_a[c + 1], bx0 = b_x[c], bx1 = b_x[c + 1], sp0 = softplus_neg8(lam[c]), sp1 = softplus_neg8(lam[c + 1]);
            for (int t0 = 0; t0 < 64; t0 += 8) {
                unsigned ga[8], gx[8], xv[8];
#pragma unroll
                for (int t = 0; t < 8; ++t) { const size_t row = row0 + t0 + t;
                    ga[t] = *(const unsigned*)(GB + row * 2048 + gcol); gx[t] = *(const unsigned*)(GB + row * 2048 + gcol + 128); xv[t] = *(const unsigned*)(xrc + row * DM + c); }
#pragma unroll
                for (int t = 0; t < 8; ++t) { float a0, b0, a1, b1, l0, l1;
                    lru_ab(bflo(ga[t]) + ba0, bflo(gx[t]) + bx0, bflo(xv[t]), sp0, a0, b0, l0);
                    lru_ab(bfhi(ga[t]) + ba1, bfhi(gx[t]) + bx1, bfhi(xv[t]), sp1, a1, b1, l1);
                    const unsigned w0 = cvt_pk_bf16(l0, b0), w1 = cvt_pk_bf16(l1, b1);
                    *(u32x2*)(LB + (row0 + t0 + t) * DM + c) = (u32x2){w0, w1};
                    const float lr0 = bflo(w0), lr1 = bflo(w1);
                    h0 = __expf(lr0) * h0 + bfhi(w0); h1 = __expf(lr1) * h1 + bfhi(w1); sl0 += lr0; sl1 += lr1; }
            }
            const int ci = (b * 64 + seg) * 1024 + c; *(f32x2*)(CLA + ci) = (f32x2){sl0, sl1}; *(f32x2*)(CH + ci) = (f32x2){h0, h1};
        } else {
            for (int s0 = 0; s0 < seg; s0 += 8) {
                f32x2 la[8], hh[8];
#pragma unroll
                for (int k = 0; k < 8; ++k) { const int sk = (s0 + k < seg) ? s0 + k : seg - 1; const int ci = (b * 64 + sk) * 1024 + c; la[k] = *(const f32x2*)(CLA + ci); hh[k] = *(const f32x2*)(CH + ci); }
#pragma unroll
                for (int k = 0; k < 8; ++k) if (s0 + k < seg) { h0 = __expf(la[k][0]) * h0 + hh[k][0]; h1 = __expf(la[k][1]) * h1 + hh[k][1]; }
            }
            for (int t0 = 0; t0 < 64; t0 += 8) {
                u32x2 lb[8]; unsigned gt[8];
#pragma unroll
                for (int t = 0; t < 8; ++t) { const size_t row = row0 + t0 + t; lb[t] = *(const u32x2*)(LB + row * DM + c); gt[t] = *(const unsigned*)(proj2 + row * 2048 + 1024 + c); }
#pragma unroll
                for (int t = 0; t < 8; ++t) {
                    h0 = __expf(bflo(lb[t].x)) * h0 + bfhi(lb[t].x); h1 = __expf(bflo(lb[t].y)) * h1 + bfhi(lb[t].y);
                    *(unsigned*)(proj2 + (row0 + t0 + t) * 2048 + c) = cvt_pk_bf16(h0 * gelu_tanh(bflo(gt[t])), h1 * gelu_tanh(bfhi(gt[t]))); }
            }
        }
    }
}

__device__ __forceinline__ void dn_local_phase(LAS unsigned char* lds, int lj, const int n_lo, const int n_cnt, const int pb, const int npb) {
    const Params p = load_params();
    const int tid = tid_fresh(), wid = tid >> 6, lane = tid & 63, fr = lane & 15, fq = lane >> 4;
    const bf16_t* proj = (const bf16_t*)(p.ws + S_PROJ); const float* BL = (const float*)(p.ws + S_BL);
    bf16_t* QGg = (bf16_t*)(p.ws + S_QG); bf16_t* KTg = (bf16_t*)(p.ws + S_KT); bf16_t* Wg = (bf16_t*)(p.ws + S_W); bf16_t* QKg = (bf16_t*)(p.ws + S_QK);
    float* GLg = (float*)(p.ws + S_GL); float* Ug = p.out;
    const float* cw = p.hyb_conv_w + (size_t)lj * 4 * 1536;
    LAS unsigned char* Kb = lds + 16896; LAS unsigned char* Qb = lds + 34304;
    LAS float* RHS = (LAS float*)(lds + 51712); LAS float* AM = (LAS float*)lds; LAS float* Gs = (LAS float*)(lds + 16384); LAS float* Bs = (LAS float*)(lds + 16640);
    for (int idx = pb; idx < 32 * n_cnt; idx += npb) {
        const int it = (idx & 31) * 64 + n_lo + (idx >> 5);
        const int n = it & 63, h = (it >> 6) & 3, b = it >> 8;
        const int rowbase = b * SEQ + n * 64;
        if (wid == 0) {
            const float bl = BL[(size_t)(rowbase + lane) * 8 + h], al = BL[(size_t)(rowbase + lane) * 8 + 4 + h];
            const float beta = sigmoidf_(bl); const float xx = al + p.hyb_dt_bias[lj * 4 + h];
            const float sp = xx > 20.f ? xx : log1pf(__expf(xx));
            float g = -__expf(p.hyb_a_log[lj * 4 + h]) * sp;
#pragma unroll
            for (int o = 1; o < 64; o <<= 1) { const float t = __shfl_up(g, o); if (lane >= o) g += t; }
            Gs[lane] = g; Bs[lane] = beta;
            if (lane == 63) GLg[it] = g;
        }
        __syncthreads();
        {
            const int r = tid >> 3, sub = tid & 7, t = n * 64 + r;
            float y[3][16];
#pragma unroll
            for (int part = 0; part < 3; ++part) {
                const int col0 = 768 + part * 512 + h * 128 + sub * 16, c0 = part * 512 + h * 128 + sub * 16;
#pragma unroll
                for (int d = 0; d < 16; ++d) y[part][d] = 0.f;
#pragma unroll
                for (int j = 0; j < 4; ++j) { const int tt = t - 3 + j;
                    if (tt >= 0) { const bf16_t* xp = proj + (size_t)(b * SEQ + tt) * HPP + col0; const u32x4 v0 = *(const u32x4*)xp, v1 = *(const u32x4*)(xp + 8);
                        const float xs[16] = {bflo(v0.x), bfhi(v0.x), bflo(v0.y), bfhi(v0.y), bflo(v0.z), bfhi(v0.z), bflo(v0.w), bfhi(v0.w), bflo(v1.x), bfhi(v1.x), bflo(v1.y), bfhi(v1.y), bflo(v1.z), bfhi(v1.z), bflo(v1.w), bfhi(v1.w)};
                        const float* wp = cw + j * 1536 + c0;
#pragma unroll
                        for (int d4 = 0; d4 < 4; ++d4) { const f32x4 wv = *(const f32x4*)(wp + d4 * 4);
#pragma unroll
                            for (int e = 0; e < 4; ++e) y[part][d4 * 4 + e] += wv[e] * xs[d4 * 4 + e]; } } }
#pragma unroll
                for (int d = 0; d < 16; ++d) y[part][d] = y[part][d] * sigmoidf_(y[part][d]);
            }
            float sq = 0.f, sk = 0.f;
#pragma unroll
            for (int d = 0; d < 16; ++d) { sq += y[0][d] * y[0][d]; sk += y[1][d] * y[1][d]; }
            sq = row8_sum(sq); sk = row8_sum(sk);
            const float rq = rsqrtf(sq + 1e-6f) * 0.08838834764831845f, rk = rsqrtf(sk + 1e-6f);
            const float Gr = Gs[r], Gl = Gs[63], eg = __expf(Gr), et = __expf(Gl - Gr), beta = Bs[r];
            float qn[16], kn[16];
#pragma unroll
            for (int d = 0; d < 16; ++d) { qn[d] = y[0][d] * rq; kn[d] = y[1][d] * rk; }
            { u32x4 a, c;
              a.x = cvt_pk_bf16(qn[0], qn[1]); a.y = cvt_pk_bf16(qn[2], qn[3]); a.z = cvt_pk_bf16(qn[4], qn[5]); a.w = cvt_pk_bf16(qn[6], qn[7]);
              c.x = cvt_pk_bf16(qn[8], qn[9]); c.y = cvt_pk_bf16(qn[10], qn[11]); c.z = cvt_pk_bf16(qn[12], qn[13]); c.w = cvt_pk_bf16(qn[14], qn[15]);
              *(LAS u32x4*)(Qb + r * 272 + sub * 32) = a; *(LAS u32x4*)(Qb + r * 272 + sub * 32 + 16) = c;
              a.x = cvt_pk_bf16(kn[0], kn[1]); a.y = cvt_pk_bf16(kn[2], kn[3]); a.z = cvt_pk_bf16(kn[4], kn[5]); a.w = cvt_pk_bf16(kn[6], kn[7]);
              c.x = cvt_pk_bf16(kn[8], kn[9]); c.y = cvt_pk_bf16(kn[10], kn[11]); c.z = cvt_pk_bf16(kn[12], kn[13]); c.w = cvt_pk_bf16(kn[14], kn[15]);
              *(LAS u32x4*)(Kb + r * 272 + sub * 32) = a; *(LAS u32x4*)(Kb + r * 272 + sub * 32 + 16) = c;
              a.x = cvt_pk_bf16(qn[0] * eg, qn[1] * eg); a.y = cvt_pk_bf16(qn[2] * eg, qn[3] * eg); a.z = cvt_pk_bf16(qn[4] * eg, qn[5] * eg); a.w = cvt_pk_bf16(qn[6] * eg, qn[7] * eg);
              c.x = cvt_pk_bf16(qn[8] * eg, qn[9] * eg); c.y = cvt_pk_bf16(qn[10] * eg, qn[11] * eg); c.z = cvt_pk_bf16(qn[12] * eg, qn[13] * eg); c.w = cvt_pk_bf16(qn[14] * eg, qn[15] * eg);
              bf16_t* qp = QGg + (size_t)it * 8192 + r * 128 + sub * 16; *(u32x4*)qp = a; *(u32x4*)(qp + 8) = c; }
            bf16_t* ktp = KTg + (size_t)it * 8192;
#pragma unroll
            for (int d = 0; d < 16; ++d) {
                RHS[r * 256 + sub * 16 + d] = y[2][d] * beta;
                RHS[r * 256 + 128 + sub * 16 + d] = kn[d] * beta * eg;
                ktp[(sub * 16 + d) * 64 + r] = f2bf(kn[d] * et);
            }
        }
        __syncthreads();
        {
            const int ti = wid >> 1, isqk = wid & 1;
            LAS unsigned char* Xb = isqk ? Qb : Kb;
            bf16_t* qkp = QKg + (size_t)it * 4096;
#pragma unroll
            for (int tj = 0; tj < 4; ++tj) {
                if (tj <= ti) {
                    f32x4 acc = (f32x4){0.f, 0.f, 0.f, 0.f};
#pragma unroll
                    for (int ks = 0; ks < 4; ++ks) {
                        const bf16x8 a = *(LAS bf16x8*)(Xb + (ti * 16 + fr) * 272 + ks * 64 + fq * 16);
                        const bf16x8 bb = *(LAS bf16x8*)(Kb + (tj * 16 + fr) * 272 + ks * 64 + fq * 16);
                        acc = MFMA16(a, bb, acc);
                    }
                    const int j = tj * 16 + fr; const float Gj = Gs[j];
#pragma unroll
                    for (int e = 0; e < 4; ++e) { const int i = ti * 16 + 4 * fq + e; const float dec = __expf(fminf(Gs[i] - Gj, 0.f));
                        if (isqk) qkp[i * 64 + j] = (i >= j) ? f2bf(acc[e] * dec) : (bf16_t)0;
                        else AM[i * 64 + j] = (i > j) ? Bs[i] * acc[e] * dec : 0.f; }
                } else if (isqk) {
                    const int j = tj * 16 + fr;
#pragma unroll
                    for (int e = 0; e < 4; ++e) qkp[(ti * 16 + 4 * fq + e) * 64 + j] = (bf16_t)0;
                }
            }
        }
        __syncthreads();
        if (tid < 256) {
            const int c = tid;
            LAS float* RHSc = RHS + c;
            float X[64];
#pragma unroll
            for (int i = 0; i < 64; ++i) {
                float a0 = RHSc[i * 256], a1 = 0.f, a2 = 0.f, a3 = 0.f;
#pragma unroll
                for (int j4 = 0; j4 < (i + 3) / 4; ++j4) {
                    const f32x4 av = *(LAS f32x4*)(AM + i * 64 + j4 * 4);
                    if (j4 * 4 + 0 < i) a0 -= av[0] * X[j4 * 4 + 0];
                    if (j4 * 4 + 1 < i) a1 -= av[1] * X[j4 * 4 + 1];
                    if (j4 * 4 + 2 < i) a2 -= av[2] * X[j4 * 4 + 2];
                    if (j4 * 4 + 3 < i) a3 -= av[3] * X[j4 * 4 + 3];
                }
                X[i] = (a0 + a1) + (a2 + a3);
            }
            if (c < 128) {
                float* up = Ug + (size_t)it * 8192; const int slice = c >> 4, nn = c & 15;
#pragma unroll
                for (int mt = 0; mt < 4; ++mt)
#pragma unroll
                    for (int qq = 0; qq < 4; ++qq) { const int i0 = mt * 16 + qq * 4;
                        *(f32x4*)(up + ((slice * 4 + mt) * 64 + qq * 16 + nn) * 4) = (f32x4){X[i0], X[i0 + 1], X[i0 + 2], X[i0 + 3]}; }
            } else {
                bf16_t* wp = Wg + (size_t)it * 8192 + (c - 128);
#pragma unroll
                for (int i = 0; i < 64; ++i) wp[i * 128] = f2bf(X[i]);
            }
        }
        __syncthreads();
    }
}

__device__ __forceinline__ void dn_scan_chain(LAS unsigned char* lds, int lj, int chain, unsigned* half_cnt, const unsigned half_need) {
    const Params p = load_params();
    const int tid = tid_fresh(), w = __builtin_amdgcn_readfirstlane(tid >> 6), lane = tid & 63, fr = lane & 15, fq = lane >> 4;
    const int b = chain >> 2, h = chain & 3;
    const bf16_t* QGg = (const bf16_t*)(p.ws + S_QG); const bf16_t* KTg = (const bf16_t*)(p.ws + S_KT); const bf16_t* Wg = (const bf16_t*)(p.ws + S_W); const bf16_t* QKg = (const bf16_t*)(p.ws + S_QK);
    const float* GLg = (const float*)(p.ws + S_GL); const float* Ug = p.out;
    bf16_t* ORAW = (bf16_t*)(p.out + (size_t)16 * 1024 * 1024);
    f32x4 S[8];
#pragma unroll
    for (int i = 0; i < 8; ++i) S[i] = (f32x4){0.f, 0.f, 0.f, 0.f};
    u32x4 st[7]; f32x4 unext[4];
#define DN_WRITE(bufb) do { LAS unsigned char* _b = lds + (bufb); \
        _Pragma("unroll") for (int i = 0; i < 2; ++i) { const int q = tid + 512 * i; \
            *(LAS u32x4*)(_b + (q >> 4) * 272 + (q & 15) * 16) = st[i]; \
            *(LAS u32x4*)(_b + 17408 + (q >> 4) * 272 + (q & 15) * 16) = st[2 + i]; \
            *(LAS u32x4*)(_b + 34816 + (q >> 3) * 144 + (q & 7) * 16) = st[4 + i]; } \
        *(LAS u32x4*)(_b + 53248 + (tid >> 3) * 144 + (tid & 7) * 16) = st[6]; } while (0)
#define DN_ISSUE_ST(it_) do { const size_t _it = (size_t)(it_); \
        const u32x4* gW = (const u32x4*)(Wg + _it * 8192); const u32x4* gQ = (const u32x4*)(QGg + _it * 8192); const u32x4* gK = (const u32x4*)(KTg + _it * 8192); const u32x4* gP = (const u32x4*)(QKg + _it * 4096); \
        st[0] = gW[tid]; st[1] = gW[tid + 512]; st[2] = gQ[tid]; st[3] = gQ[tid + 512]; st[4] = gK[tid]; st[5] = gK[tid + 512]; st[6] = gP[tid]; } while (0)
#define DN_ISSUE_U(it_) do { const size_t _it = (size_t)(it_); \
        _Pragma("unroll") for (int mt = 0; mt < 4; ++mt) unext[mt] = *(const f32x4*)(Ug + _it * 8192 + ((w * 4 + mt) * 64 + lane) * 4); } while (0)
    DN_ISSUE_ST(chain * 64);
    DN_ISSUE_U(chain * 64);
    float gln = GLg[chain * 64];
    DN_WRITE(0);
    DN_ISSUE_ST(chain * 64 + 1);
    __syncthreads();
    for (int n = 0; n < 64; ++n) {
        const int it = chain * 64 + n;
        f32x4 ucur[4];
#pragma unroll
        for (int mt = 0; mt < 4; ++mt) ucur[mt] = unext[mt];
        const float eg = __expf(gln);
        if (n == 22 || n == 42) {
            if (tid == 0) { unsigned* hc = half_cnt + (n == 22 ? 0 : 32); XB_SPIN(xb_ld(hc) < half_need, (unsigned*)(p.ws + OFF_BAR)); }
            __syncthreads();
            __builtin_amdgcn_fence(__ATOMIC_ACQUIRE, "agent"); asm volatile("s_waitcnt vmcnt(0)" ::: "memory");
        }
        const int itn = n < 63 ? it + 1 : it, itn2 = n < 62 ? it + 2 : it;
        DN_ISSUE_U(itn);
        gln = GLg[itn];
        const int rowb = b * SEQ + n * 64;
        if (n > 0) {
            LAS unsigned char* ob = lds + 124928 + ((n - 1) & 1) * 16384;
#pragma unroll
            for (int i = 0; i < 2; ++i) { const int q = tid + 512 * i, row = q >> 4, cc = q & 15;
                *(u32x4*)(ORAW + (size_t)(rowb - 64 + row) * 512 + h * 128 + cc * 8) = *(LAS u32x4*)(ob + row * 256 + cc * 16); }
        }
        LAS unsigned char* bb = lds + (n & 1) * 62464;
        bf16x8 Sb[4];
#pragma unroll
        for (int ks = 0; ks < 4; ++ks) Sb[ks] = pack8(S[2 * ks], S[2 * ks + 1]);
        f32x4 vn[4], oa[4];
#pragma unroll
        for (int mt = 0; mt < 4; ++mt) {
            bf16x8 Aw[4], Aq[4];
#pragma unroll
            for (int ks = 0; ks < 4; ++ks) { Aw[ks] = ldA_split(bb, 16 * mt + fr, 32 * ks + 4 * fq, 272); Aq[ks] = ldA_split(bb + 17408, 16 * mt + fr, 32 * ks + 4 * fq, 272); }
            __builtin_amdgcn_sched_barrier(0);
            f32x4 a1 = (f32x4){0.f, 0.f, 0.f, 0.f}, a2 = (f32x4){0.f, 0.f, 0.f, 0.f};
#pragma unroll
            for (int ks = 0; ks < 4; ++ks) { a1 = MFMA16(Aw[ks], Sb[ks], a1); a2 = MFMA16(Aq[ks], Sb[ks], a2); }
            vn[mt] = ucur[mt] - a1; oa[mt] = a2;
            __builtin_amdgcn_sched_barrier(0);
        }
        bf16x8 Vb[2];
        Vb[0] = pack8(vn[0], vn[1]); Vb[1] = pack8(vn[2], vn[3]);
#pragma unroll
        for (int hf = 0; hf < 2; ++hf) {
            bf16x8 Ak[4][2];
#pragma unroll
            for (int d = 0; d < 4; ++d)
#pragma unroll
                for (int k2 = 0; k2 < 2; ++k2) Ak[d][k2] = ldA_split(bb + 34816, 16 * (4 * hf + d) + fr, 32 * k2 + 4 * fq, 144);
            __builtin_amdgcn_sched_barrier(0);
#pragma unroll
            for (int d = 0; d < 4; ++d) { const int dt = 4 * hf + d; S[dt] = S[dt] * eg;
#pragma unroll
                for (int k2 = 0; k2 < 2; ++k2) S[dt] = MFMA16(Ak[d][k2], Vb[k2], S[dt]); }
            __builtin_amdgcn_sched_barrier(0);
        }
        {
            bf16x8 Ap[4][2];
#pragma unroll
            for (int mt = 0; mt < 4; ++mt)
#pragma unroll
                for (int k2 = 0; k2 < 2; ++k2) Ap[mt][k2] = ldA_split(bb + 53248, 16 * mt + fr, 32 * k2 + 4 * fq, 144);
            __builtin_amdgcn_sched_barrier(0);
#pragma unroll
            for (int mt = 0; mt < 4; ++mt)
#pragma unroll
                for (int k2 = 0; k2 < 2; ++k2) oa[mt] = MFMA16(Ap[mt][k2], Vb[k2], oa[mt]);
        }
        { LAS unsigned char* ob = lds + 124928 + (n & 1) * 16384 + (16 * w + fr) * 2;
#pragma unroll
          for (int mt = 0; mt < 4; ++mt)
#pragma unroll
              for (int e = 0; e < 4; ++e) *(LAS bf16_t*)(ob + (16 * mt + 4 * fq + e) * 256) = f2bf(oa[mt][e]); }
        DN_WRITE(((n + 1) & 1) * 62464);
        DN_ISSUE_ST(itn2);
        __syncthreads();
    }
    {
        const int rowl = b * SEQ + 63 * 64; LAS unsigned char* ob = lds + 124928 + 16384;
#pragma unroll
        for (int i = 0; i < 2; ++i) { const int q = tid + 512 * i, row = q >> 4, cc = q & 15;
            *(u32x4*)(ORAW + (size_t)(rowl + row) * 512 + h * 128 + cc * 8) = *(LAS u32x4*)(ob + row * 256 + cc * 16); }
    }
#undef DN_ISSUE_ST
#undef DN_ISSUE_U
#undef DN_WRITE
}

__device__ __forceinline__ void dn_gate_phase(int lj) {
    const Params p = load_params();
    const int tid = tid_fresh();
    bf16_t* proj = (bf16_t*)(p.ws + S_PROJ); const bf16_t* ORAW = (const bf16_t*)(p.out + (size_t)16 * 1024 * 1024);
    const int sub = tid & 15;
    const f32x4 nw0 = *(const f32x4*)(p.hyb_norm_w + lj * 128 + sub * 8), nw1 = *(const f32x4*)(p.hyb_norm_w + lj * 128 + sub * 8 + 4);
    const float nwv[8] = {nw0[0], nw0[1], nw0[2], nw0[3], nw1[0], nw1[1], nw1[2], nw1[3]};
    const int pstep = (gridDim.x * 512) >> 4;
    for (int pr0 = (blockIdx.x * 512 + tid) >> 4; pr0 < MTOK * 4; pr0 += 2 * pstep) {
        u32x4 ovv[2], zvv[2];
#pragma unroll
        for (int k = 0; k < 2; ++k) { const int pr = (pr0 + k * pstep < MTOK * 4) ? pr0 + k * pstep : pr0; const int row = pr >> 2, hh = pr & 3;
            ovv[k] = *(const u32x4*)(ORAW + (size_t)row * 512 + hh * 128 + sub * 8); zvv[k] = *(const u32x4*)(proj + (size_t)row * HPP + 2304 + hh * 128 + sub * 8); }
#pragma unroll
        for (int k = 0; k < 2; ++k) {
            const int pr = pr0 + k * pstep; if (pr >= MTOK * 4) break;
            const int row = pr >> 2, hh = pr & 3;
            const u32x4 ov = ovv[k], zv = zvv[k];
            bf16_t* zp = proj + (size_t)row * HPP + 2304 + hh * 128 + sub * 8;
            const float o[8] = {bflo(ov.x), bfhi(ov.x), bflo(ov.y), bfhi(ov.y), bflo(ov.z), bfhi(ov.z), bflo(ov.w), bfhi(ov.w)};
            const float z[8] = {bflo(zv.x), bfhi(zv.x), bflo(zv.y), bfhi(zv.y), bflo(zv.z), bfhi(zv.z), bflo(zv.w), bfhi(zv.w)};
            float ss = 0.f;
#pragma unroll
            for (int d = 0; d < 8; ++d) ss += o[d] * o[d];
            ss = row16_sum(ss);
            const float rstd = rsqrtf(ss * (1.0f / 128.0f) + 1e-6f);
            float r[8];
#pragma unroll
            for (int d = 0; d < 8; ++d) r[d] = o[d] * rstd * nwv[d] * (z[d] * sigmoidf_(z[d]));
            u32x4 w; w.x = cvt_pk_bf16(r[0], r[1]); w.y = cvt_pk_bf16(r[2], r[3]); w.z = cvt_pk_bf16(r[4], r[5]); w.w = cvt_pk_bf16(r[6], r[7]);
            *(u32x4*)zp = w;
        }
    }
}

__device__ __forceinline__ void attn_items(LAS unsigned char* lds, int lj, int ab, int nab) {
    const Params p = load_params();
    const int tid = tid_fresh(), w = __builtin_amdgcn_readfirstlane(tid >> 6), lane = tid & 63, fr = lane & 15, fq = lane >> 4;
    bf16_t* proj = (bf16_t*)(p.ws + S_PROJ); const float* rope = (const float*)(p.ws + OFF_ROPE);
    LAS unsigned char* KS = lds; LAS unsigned char* VT = lds + 36864;
    for (int item = ab; item < 512; item += nab) {
        const int kvh = item & 1, nb = (item >> 1) & 31, b = item >> 6;
        {
            const int kb = tid >> 1, hf = tid & 1, pos = (nb - 1) * 128 + kb;
            u32x4 o1a = (u32x4){0u, 0u, 0u, 0u}, o1b = o1a, o2a = o1a, o2b = o1a;
            if (pos >= 0) {
                const bf16_t* kp = proj + (size_t)(b * SEQ + pos) * HPP + 512 + kvh * 64 + 16 * hf;
                const u32x4 x1a = *(const u32x4*)kp, x1b = *(const u32x4*)(kp + 8), x2a = *(const u32x4*)(kp + 32), x2b = *(const u32x4*)(kp + 40);
                const float x1[16] = {bflo(x1a.x), bfhi(x1a.x), bflo(x1a.y), bfhi(x1a.y), bflo(x1a.z), bfhi(x1a.z), bflo(x1a.w), bfhi(x1a.w), bflo(x1b.x), bfhi(x1b.x), bflo(x1b.y), bfhi(x1b.y), bflo(x1b.z), bfhi(x1b.z), bflo(x1b.w), bfhi(x1b.w)};
                const float x2[16] = {bflo(x2a.x), bfhi(x2a.x), bflo(x2a.y), bfhi(x2a.y), bflo(x2a.z), bfhi(x2a.z), bflo(x2a.w), bfhi(x2a.w), bflo(x2b.x), bfhi(x2b.x), bflo(x2b.y), bfhi(x2b.y), bflo(x2b.z), bfhi(x2b.z), bflo(x2b.w), bfhi(x2b.w)};
                const float* rp = rope + ((size_t)pos * 32 + 16 * hf) * 2;
                float r1[16], r2[16];
#pragma unroll
                for (int d2 = 0; d2 < 8; ++d2) { const f32x4 cs = *(const f32x4*)(rp + d2 * 4);
                    r1[2 * d2] = x1[2 * d2] * cs[0] - x2[2 * d2] * cs[1]; r2[2 * d2] = x2[2 * d2] * cs[0] + x1[2 * d2] * cs[1];
                    r1[2 * d2 + 1] = x1[2 * d2 + 1] * cs[2] - x2[2 * d2 + 1] * cs[3]; r2[2 * d2 + 1] = x2[2 * d2 + 1] * cs[2] + x1[2 * d2 + 1] * cs[3]; }
                o1a.x = cvt_pk_bf16(r1[0], r1[1]); o1a.y = cvt_pk_bf16(r1[2], r1[3]); o1a.z = cvt_pk_bf16(r1[4], r1[5]); o1a.w = cvt_pk_bf16(r1[6], r1[7]);
                o1b.x = cvt_pk_bf16(r1[8], r1[9]); o1b.y = cvt_pk_bf16(r1[10], r1[11]); o1b.z = cvt_pk_bf16(r1[12], r1[13]); o1b.w = cvt_pk_bf16(r1[14], r1[15]);
                o2a.x = cvt_pk_bf16(r2[0], r2[1]); o2a.y = cvt_pk_bf16(r2[2], r2[3]); o2a.z = cvt_pk_bf16(r2[4], r2[5]); o2a.w = cvt_pk_bf16(r2[6], r2[7]);
                o2b.x = cvt_pk_bf16(r2[8], r2[9]); o2b.y = cvt_pk_bf16(r2[10], r2[11]); o2b.z = cvt_pk_bf16(r2[12], r2[13]); o2b.w = cvt_pk_bf16(r2[14], r2[15]);
            }
            LAS unsigned char* kd = KS + kb * 144 + hf * 32;
            *(LAS u32x4*)kd = o1a; *(LAS u32x4*)(kd + 16) = o1b; *(LAS u32x4*)(kd + 64) = o2a; *(LAS u32x4*)(kd + 80) = o2b;
        }
        {
#pragma unroll
            for (int i = 0; i < 4; ++i) { const int q = tid + 512 * i, key = q >> 3, dc = q & 7, pos = (nb - 1) * 128 + key;
                u32x4 v = (u32x4){0u, 0u, 0u, 0u};
                if (pos >= 0) v = *(const u32x4*)(proj + (size_t)(b * SEQ + pos) * HPP + 640 + kvh * 64 + 8 * dc);
                LAS bf16_t* vd = (LAS bf16_t*)VT + (8 * dc) * 280 + key;
                vd[0] = (bf16_t)(v.x & 0xffffu); vd[280] = (bf16_t)(v.x >> 16); vd[2 * 280] = (bf16_t)(v.y & 0xffffu); vd[3 * 280] = (bf16_t)(v.y >> 16);
                vd[4 * 280] = (bf16_t)(v.z & 0xffffu); vd[5 * 280] = (bf16_t)(v.z >> 16); vd[6 * 280] = (bf16_t)(v.w & 0xffffu); vd[7 * 280] = (bf16_t)(v.w >> 16); }
            if (tid < 128) *(LAS u32x4*)(VT + (tid >> 1) * 560 + 512 + (tid & 1) * 16) = (u32x4){0u, 0u, 0u, 0u};
        }
        __syncthreads();
        const int qi = 16 * w + fr, pos_q = nb * 128 + qi, rowq = b * SEQ + pos_q;
        const int dl = fr - 4 * fq;
#pragma unroll 1
        for (int g = 0; g < 4; ++g) {
            const int head = kvh * 4 + g;
            bf16x8 Qf[2];
            { const bf16_t* qp = proj + (size_t)rowq * HPP + head * 64 + 8 * fq;
              const u32x4 xa = *(const u32x4*)qp, xb = *(const u32x4*)(qp + 32);
              const float x1[8] = {bflo(xa.x), bfhi(xa.x), bflo(xa.y), bfhi(xa.y), bflo(xa.z), bfhi(xa.z), bflo(xa.w), bfhi(xa.w)};
              const float x2[8] = {bflo(xb.x), bfhi(xb.x), bflo(xb.y), bfhi(xb.y), bflo(xb.z), bfhi(xb.z), bflo(xb.w), bfhi(xb.w)};
              const float* rp = rope + ((size_t)pos_q * 32 + 8 * fq) * 2;
              float r1[8], r2[8];
#pragma unroll
              for (int d2 = 0; d2 < 4; ++d2) { const f32x4 cs = *(const f32x4*)(rp + d2 * 4);
                  r1[2 * d2] = (x1[2 * d2] * cs[0] - x2[2 * d2] * cs[1]) * 0.125f; r2[2 * d2] = (x2[2 * d2] * cs[0] + x1[2 * d2] * cs[1]) * 0.125f;
                  r1[2 * d2 + 1] = (x1[2 * d2 + 1] * cs[2] - x2[2 * d2 + 1] * cs[3]) * 0.125f; r2[2 * d2 + 1] = (x2[2 * d2 + 1] * cs[2] + x1[2 * d2 + 1] * cs[3]) * 0.125f; }
              u32x4 a, c; a.x = cvt_pk_bf16(r1[0], r1[1]); a.y = cvt_pk_bf16(r1[2], r1[3]); a.z = cvt_pk_bf16(r1[4], r1[5]); a.w = cvt_pk_bf16(r1[6], r1[7]);
              c.x = cvt_pk_bf16(r2[0], r2[1]); c.y = cvt_pk_bf16(r2[2], r2[3]); c.z = cvt_pk_bf16(r2[4], r2[5]); c.w = cvt_pk_bf16(r2[6], r2[7]);
              Qf[0] = __builtin_bit_cast(bf16x8, a); Qf[1] = __builtin_bit_cast(bf16x8, c); }
            const float sink = p.hyb_sinks[lj * 8 + head];
            f32x4 sc[9];
            float mx = sink;
#pragma unroll
            for (int tt = 0; tt < 9; ++tt) {
                const int kt = w + tt;
                const bf16x8 k0 = *(LAS bf16x8*)(KS + (16 * kt + fr) * 144 + fq * 16), k1 = *(LAS bf16x8*)(KS + (16 * kt + fr) * 144 + 64 + fq * 16);
                f32x4 a = (f32x4){0.f, 0.f, 0.f, 0.f};
                a = MFMA16(k0, Qf[0], a); a = MFMA16(k1, Qf[1], a);
                const bool dead = (nb == 0) && (kt < 8);
#pragma unroll
                for (int e = 0; e < 4; ++e) { bool valid = !dead;
                    if (tt == 0) valid = valid && (e > dl);
                    if (tt == 8) valid = valid && (e <= dl);
                    a[e] = valid ? a[e] : -INFINITY; mx = fmaxf(mx, a[e]); }
                sc[tt] = a;
            }
            mx = fmaxf(mx, __shfl_xor(mx, 16)); mx = fmaxf(mx, __shfl_xor(mx, 32));
            float l = 0.f;
#pragma unroll
            for (int tt = 0; tt < 9; ++tt)
#pragma unroll
                for (int e = 0; e < 4; ++e) { const float pv = __expf(sc[tt][e] - mx); sc[tt][e] = pv; l += pv; }
            l += __shfl_xor(l, 16); l += __shfl_xor(l, 32);
            l += __expf(sink - mx);
            const float inv = 1.0f / l;
            f32x4 oacc[4];
#pragma unroll
            for (int mt = 0; mt < 4; ++mt) oacc[mt] = (f32x4){0.f, 0.f, 0.f, 0.f};
#pragma unroll
            for (int kk = 0; kk < 5; ++kk) {
                const bf16x8 Pb = pack8(sc[2 * kk], kk < 4 ? sc[2 * kk + 1] : (f32x4){0.f, 0.f, 0.f, 0.f});
                const int key0 = 16 * (w + 2 * kk) + 4 * fq;
#pragma unroll
                for (int mt = 0; mt < 4; ++mt) oacc[mt] = MFMA16(ldA_split(VT, 16 * mt + fr, key0, 560), Pb, oacc[mt]);
            }
            bf16_t* op = proj + (size_t)rowq * HPP + 1792 + head * 64 + 4 * fq;
#pragma unroll
            for (int mt = 0; mt < 4; ++mt) { u32x2 o; o.x = cvt_pk_bf16(oacc[mt][0] * inv, oacc[mt][1] * inv); o.y = cvt_pk_bf16(oacc[mt][2] * inv, oacc[mt][3] * inv); *(u32x2*)(op + 16 * mt) = o; }
        }
        __syncthreads();
    }
}

#define GSYNC() do { TSM(ph_cls); xcd_barrier((unsigned*)(load_params().ws + OFF_BAR), xb_x, (volatile LAS unsigned*)(lds + LDS_CTL + 128)); TSM(2); } while (0)
template <int layer>
__device__ __forceinline__ void layer_body(LAS unsigned char* lds, const unsigned xb_x, const int G, const int bid) {
    int ph_cls = 0; (void)ph_cls;
        const int lj = layer >> 1;
        if ((layer & 1) == 0) {
            {
                const Params p = load_params();
                pg8::Gemm g{(const bf16_t*)(p.ws + OFF_XB), (const bf16_t*)(p.ws + WB_HIN) + (size_t)lj * 3072 * 1024, MTOK, 3072, 1024, 1024};
                pg8::Order S; S.init(MTOK, 3072, G, bid, 0);
                pg8::EpiProjHyb E{(bf16_t*)(p.ws + S_PROJ), (float*)(p.ws + S_BL)};
                PHC(1); pg8::gemm_phase(lds, g, S, E);
            }
            GSYNC();
            PHC(3); dn_local_phase(lds, lj, 0, 24, bid, G);
            GSYNC();
            PHC(7);
            {
                unsigned* half_cnt = (unsigned*)(load_params().ws + OFF_BAR) + 4096 + 64 * lj;
                if (bid < 32) dn_scan_chain(lds, lj, bid, half_cnt, (unsigned)(G - 32));
                else {
                    dn_local_phase(lds, lj, 24, 20, bid - 32, G - 32);
                    asm volatile("s_waitcnt vmcnt(0)" ::: "memory"); __syncthreads();
                    if (threadIdx.x == 0) { __builtin_amdgcn_fence(__ATOMIC_RELEASE, "agent"); asm volatile("s_waitcnt vmcnt(0)" ::: "memory"); (void)xb_add(half_cnt, 1u); }
                    dn_local_phase(lds, lj, 44, 20, bid - 32, G - 32);
                    asm volatile("s_waitcnt vmcnt(0)" ::: "memory"); __syncthreads();
                    if (threadIdx.x == 0) { __builtin_amdgcn_fence(__ATOMIC_RELEASE, "agent"); asm volatile("s_waitcnt vmcnt(0)" ::: "memory"); (void)xb_add(half_cnt + 32, 1u); }
                    attn_items(lds, lj, bid - 32, G - 32);
                }
            }
            GSYNC();
            PHC(3); dn_gate_phase(lj);
            GSYNC();
            {
                const Params p = load_params();
                pg8::Gemm g{(const bf16_t*)(p.ws + S_PROJ) + 1792, (const bf16_t*)(p.ws + WB_HOUT) + (size_t)lj * 1024 * 1024, MTOK, 1024, 1024, HPP};
                pg8::Order S; S.init(MTOK, 1024, G, bid, 0);
                pg8::EpiResid E{(const bf16_t*)(p.ws + OFF_XB), (bf16_t*)(p.ws + OFF_Y)};
                PHC(1); pg8::gemm_phase(lds, g, S, E);
            }
        } else {
            {
                const Params p = load_params();
                pg8::Gemm g{(const bf16_t*)(p.ws + OFF_XB), (const bf16_t*)(p.ws + WB_RIN) + (size_t)lj * 2048 * 1024, MTOK, 2048, 1024, 1024};
                pg8::Order S; S.init(MTOK, 2048, G, bid, 0);
                pg8::EpiBf16<0> E{(bf16_t*)(p.ws + S_PROJ2), 2048};
                PHC(1); pg8::gemm_phase(lds, g, S, E);
            }
            GSYNC();
            { const Params p = load_params();
              PHC(4); rconv_phase((const bf16_t*)(p.ws + S_PROJ2), p.rec_conv_w + (size_t)lj * 4 * 1024, p.rec_conv_b + lj * 1024, (bf16_t*)(p.ws + S_XRC)); }
            GSYNC();
            {
                const Params p = load_params();
                pg8::Gemm g{(const bf16_t*)(p.ws + S_XRC), (const bf16_t*)(p.ws + WB_RG) + (size_t)lj * 2048 * 256, MTOK, 2048, 256, 1024};
                pg8::Order S; S.init(MTOK, 2048, G, bid, 1);
                pg8::EpiBf16<0> E{(bf16_t*)(p.ws + S_LA), 2048};
                PHC(1); pg8::gemm_phase(lds, g, S, E);
            }
            GSYNC();
            { const Params p = load_params(); PHC(4); rscan_phase<1>((const bf16_t*)(p.ws + S_LA), (const bf16_t*)(p.ws + S_XRC), p.rec_b_a + lj * 1024, p.rec_b_x + lj * 1024, p.rec_lambda + lj * 1024, (float*)(p.ws + S_CLA), (float*)(p.ws + S_CH), (bf16_t*)(p.ws + S_PROJ2), (unsigned*)p.out); }
            GSYNC();
            { const Params p = load_params(); PHC(4); rscan_phase<2>((const bf16_t*)(p.ws + S_LA), (const bf16_t*)(p.ws + S_XRC), p.rec_b_a + lj * 1024, p.rec_b_x + lj * 1024, p.rec_lambda + lj * 1024, (float*)(p.ws + S_CLA), (float*)(p.ws + S_CH), (bf16_t*)(p.ws + S_PROJ2), (unsigned*)p.out); }
            GSYNC();
            {
                const Params p = load_params();
                pg8::Gemm g{(const bf16_t*)(p.ws + S_PROJ2), (const bf16_t*)(p.ws + WB_ROUT) + (size_t)lj * 1024 * 1024, MTOK, 1024, 1024, 2048};
                pg8::Order S; S.init(MTOK, 1024, G, bid, 0);
                pg8::EpiResid E{(const bf16_t*)(p.ws + OFF_XB), (bf16_t*)(p.ws + OFF_Y)};
                PHC(1); pg8::gemm_phase(lds, g, S, E);
            }
        }
        GSYNC();
        { const Params p = load_params(); PHC(5); ln_phase((const bf16_t*)(p.ws + OFF_Y), p.ln1_g + layer * 1024, p.ln1_b + layer * 1024, (bf16_t*)(p.ws + OFF_XB), nullptr); }
        GSYNC();
        {
            const Params p = load_params();
            pg8::Gemm g{(const bf16_t*)(p.ws + OFF_XB), (const bf16_t*)(p.ws + WB_W1) + (size_t)layer * 4096 * 1024, MTOK, 4096, 1024, 1024};
            pg8::Order S; S.init(MTOK, 4096, G, bid, 0);
            pg8::EpiBf16<1> E{(bf16_t*)(p.ws + S_H), 4096};
            PHC(1); pg8::gemm_phase(lds, g, S, E);
        }
        GSYNC();
        {
            const Params p = load_params();
            pg8::Gemm g{(const bf16_t*)(p.ws + S_H), (const bf16_t*)(p.ws + WB_W2) + (size_t)layer * 1024 * 4096, MTOK, 1024, 4096, 4096};
            pg8::Order S; S.init(MTOK, 1024, G, bid, 0);
            pg8::EpiResid E{(const bf16_t*)(p.ws + OFF_XB), (bf16_t*)(p.ws + OFF_Y)};
            PHC(1); pg8::gemm_phase(lds, g, S, E);
        }
        GSYNC();
        { const Params p = load_params(); PHC(5); ln_phase((const bf16_t*)(p.ws + OFF_Y), p.ln2_g + layer * 1024, p.ln2_b + layer * 1024, (bf16_t*)(p.ws + OFF_XB), layer == 3 ? p.out : nullptr); }
        if (layer < 3) GSYNC();
#ifdef TS_SELECT
        else GSYNC();
#endif
}

__global__ void __launch_bounds__(512) mega_fwd(Params p_unused) {
    extern __shared__ __attribute__((aligned(16))) unsigned char smem_raw[];
    LAS unsigned char* lds = (LAS unsigned char*)smem_raw;
    cg::grid_group grid = cg::this_grid();
    grid.sync();
    const int G = gridDim.x, bid = blockIdx.x;
    if (threadIdx.x < 2) ((LAS unsigned*)(lds + LDS_CTL + 128))[threadIdx.x] = 0u;
    __syncthreads();
    const unsigned xb_x = xb_xcc_id();
    if (threadIdx.x == 0) (void)xb_add(&((unsigned*)(load_params().ws + OFF_BAR))[XB_XCNT(xb_x)], 1u);
#ifdef TS_SELECT
    int ph_cls = 0;
    if (threadIdx.x < 64) ((LAS unsigned*)(lds + LDS_CTL))[threadIdx.x] = 0u;
    __syncthreads();
    if (blockIdx.x == TS_BLOCK && threadIdx.x == 0) { ((LAS unsigned*)(lds + LDS_CTL))[0] = (unsigned)__builtin_amdgcn_s_memrealtime(); ((LAS unsigned*)(lds + LDS_CTL))[1] = ((LAS unsigned*)(lds + LDS_CTL))[0]; }
#endif

    prep_phase(lds);
    GSYNC();

    layer_body<0>(lds, xb_x, G, bid);
    layer_body<1>(lds, xb_x, G, bid);
    layer_body<2>(lds, xb_x, G, bid);
    layer_body<3>(lds, xb_x, G, bid);
#ifdef TS_SELECT
    if (blockIdx.x == TS_BLOCK) {
        LAS unsigned* tw = (LAS unsigned*)(lds + LDS_CTL);
        unsigned ticks = (TS_SELECT == 6) ? (tw[0] - tw[1]) : tw[2 + TS_SELECT];
        const unsigned K = ticks / 50u; float* o = load_params().out;
        for (unsigned i = threadIdx.x; i < K; i += 512) o[i] += 0.09f;
    }
#endif
}

extern "C" void kernel_launch(void* const* d_in, const int* in_sizes, int n_in, void* d_out, int out_size, void* d_ws, size_t ws_size, hipStream_t stream) {
    static int grid = 0;
    if (grid == 0) {
        if (n_in != 23 || out_size != MTOK * DM || ws_size < WS_NEED) { fprintf(stderr, "kernel_launch: unexpected shapes (n_in %d, out %d, ws %zu)\n", n_in, out_size, ws_size); grid = -1; return; }
        int dev = 0, cus = 0, per_cu = 0;
        (void)hipGetDevice(&dev); (void)hipDeviceGetAttribute(&cus, hipDeviceAttributeMultiprocessorCount, dev);
        if (hipFuncSetAttribute((const void*)mega_fwd, hipFuncAttributeMaxDynamicSharedMemorySize, LDS_BYTES) != hipSuccess) { fprintf(stderr, "kernel_launch: hipFuncSetAttribute failed\n"); grid = -1; return; }
        (void)hipOccupancyMaxActiveBlocksPerMultiprocessor(&per_cu, (const void*)mega_fwd, 512, LDS_BYTES);
        if (per_cu < 1) { fprintf(stderr, "kernel_launch: occupancy query says 0\n"); per_cu = 1; }
        (void)hipGetLastError();
        grid = cus;
    }
    if (grid < 0) return;
    (void)hipMemsetAsync((char*)d_ws + OFF_BAR, 0, 32768, stream);
    Params p{};
    const float** pp = (const float**)&p;
    for (int i = 0; i < 23; ++i) pp[i] = (const float*)d_in[i];
    p.out = (float*)d_out; p.ws = (unsigned char*)d_ws;
    void* args[] = {&p};
    hipError_t e = hipLaunchCooperativeKernel((const void*)mega_fwd, dim3(grid), dim3(512), args, LDS_BYTES, stream);
    if (e != hipSuccess) fprintf(stderr, "cooperative launch failed: %s (grid %d)\n", hipGetErrorString(e), grid);
}
```

```cpp
#include <hip/hip_runtime.h>
#include <hip/hip_cooperative_groups.h>
#include <cstdio>
#include <cstdint>
namespace cg = cooperative_groups;

#define LAS __attribute__((address_space(3)))
typedef unsigned short bf16_t;
typedef short bf16x8 __attribute__((ext_vector_type(8)));
typedef short bf16x4 __attribute__((ext_vector_type(4)));
typedef float f32x4 __attribute__((ext_vector_type(4)));
typedef float f32x2 __attribute__((ext_vector_type(2)));
typedef unsigned u32x4 __attribute__((ext_vector_type(4)));
typedef unsigned u32x2 __attribute__((ext_vector_type(2)));

constexpr int MTOK = 32768, DM = 1024, SEQ = 4096;
constexpr int HPP = 3072;
constexpr float DN_ALPHA = 1.6817928305074290f;
constexpr size_t MiB = 1024ull * 1024ull;
constexpr size_t WB_HIN = 0;
constexpr size_t WB_HOUT = WB_HIN + 2ull * 3072 * 1024 * 2;
constexpr size_t WB_RIN = WB_HOUT + 2ull * 1024 * 1024 * 2;
constexpr size_t WB_RG = WB_RIN + 2ull * 2048 * 1024 * 2;
constexpr size_t WB_ROUT = WB_RG + 2ull * 2048 * 256 * 2;
constexpr size_t WB_W1 = WB_ROUT + 2ull * 1024 * 1024 * 2;
constexpr size_t WB_W2 = WB_W1 + 4ull * 4096 * 1024 * 2;
constexpr size_t WB_END = WB_W2 + 4ull * 4096 * 1024 * 2;
static_assert(WB_END <= 96 * MiB, "weights");
constexpr size_t OFF_XB = 96 * MiB;
constexpr size_t OFF_ROPE = 160 * MiB;
constexpr size_t OFF_BAR = 161 * MiB;
constexpr size_t OFF_SCR = 162 * MiB;
constexpr size_t S_PROJ = OFF_SCR;
constexpr size_t S_BL = S_PROJ + 192 * MiB;
constexpr size_t S_QG = S_BL + 1 * MiB;
constexpr size_t S_KT = S_QG + 32 * MiB;
constexpr size_t S_W = S_KT + 32 * MiB;
constexpr size_t S_QK = S_W + 32 * MiB;
constexpr size_t S_GL = S_QK + 16 * MiB;
constexpr size_t S_PROJ2 = OFF_SCR;
constexpr size_t S_XRC = S_PROJ2 + 128 * MiB;
constexpr size_t S_LA = S_XRC + 64 * MiB;
constexpr size_t S_CLA = S_LA + 128 * MiB;
constexpr size_t S_CH = S_CLA + 2 * MiB;
constexpr size_t S_H = OFF_SCR;
constexpr size_t OFF_Y = 420 * MiB;
constexpr size_t WS_NEED = OFF_SCR + 326 * MiB;
constexpr int LDS_CTL = 157696;
constexpr int LDS_BYTES = LDS_CTL + 256;

struct Params {
    const float* x; const float* hyb_w_in; const float* hyb_sinks; const float* hyb_conv_w; const float* hyb_a_log; const float* hyb_dt_bias; const float* hyb_norm_w; const float* hyb_w_out;
    const float* rec_w_in; const float* rec_conv_w; const float* rec_conv_b; const float* rec_w_a; const float* rec_b_a; const float* rec_w_x; const float* rec_b_x; const float* rec_lambda; const float* rec_w_out;
    const float* ln1_g; const float* ln1_b; const float* mlp_w1; const float* mlp_w2; const float* ln2_g; const float* ln2_b;
    float* out; unsigned char* ws;
};

typedef const __attribute__((address_space(4))) Params* KParamsPtr;
__device__ __forceinline__ Params load_params() {
#if defined(__HIP_DEVICE_COMPILE__)
    KParamsPtr k = (KParamsPtr)__builtin_amdgcn_kernarg_segment_ptr(); asm volatile("" : "+s"(k));
    Params r; const __attribute__((address_space(4))) unsigned long long* q = (const __attribute__((address_space(4))) unsigned long long*)k; const char** d = (const char**)&r;
#pragma unroll
    for (int i = 0; i < (int)(sizeof(Params) / 8); ++i) { const __attribute__((address_space(1))) char* gp = (const __attribute__((address_space(1))) char*)q[i]; d[i] = (const char*)gp; }
    return r;
#else
    return Params{};
#endif
}
__device__ __forceinline__ int tid_fresh() { int t = threadIdx.x; asm volatile("" : "+v"(t)); return t; }
typedef __bf16 bf16x2_t __attribute__((ext_vector_type(2)));
__device__ __forceinline__ unsigned cvt_pk_bf16(float lo, float hi) { const f32x2 v = {lo, hi}; const bf16x2_t b = __builtin_convertvector(v, bf16x2_t); return __builtin_bit_cast(unsigned, b); }
__device__ __forceinline__ bf16_t f2bf(float f) { return (bf16_t)(cvt_pk_bf16(f, 0.f) & 0xffffu); }
__device__ __forceinline__ float bf2f(bf16_t b) { return __uint_as_float(((unsigned)b) << 16); }
__device__ __forceinline__ float bflo(unsigned u) { return __uint_as_float(u << 16); }
__device__ __forceinline__ float bfhi(unsigned u) { return __uint_as_float(u & 0xffff0000u); }
__device__ __forceinline__ float sigmoidf_(float x) { return 1.0f / (1.0f + __expf(-x)); }
__device__ __forceinline__ bf16x8 pack8(const f32x4 a, const f32x4 b) {
    u32x4 w; w.x = cvt_pk_bf16(a[0], a[1]); w.y = cvt_pk_bf16(a[2], a[3]); w.z = cvt_pk_bf16(b[0], b[1]); w.w = cvt_pk_bf16(b[2], b[3]);
    return __builtin_bit_cast(bf16x8, w);
}
__device__ __forceinline__ bf16x8 ldA_split(LAS unsigned char* base, int row, int col, int strideB) {
    const u32x2 lo = *(LAS u32x2*)(base + row * strideB + col * 2);
    const u32x2 hi = *(LAS u32x2*)(base + row * strideB + (col + 16) * 2);
    u32x4 w; w.x = lo.x; w.y = lo.y; w.z = hi.x; w.w = hi.y;
    return __builtin_bit_cast(bf16x8, w);
}
#define DPP_ADD(s, ctrl) ((s) + __builtin_bit_cast(float, __builtin_amdgcn_update_dpp(0, __builtin_bit_cast(int, (s)), (ctrl), 0xF, 0xF, true)))
__device__ __forceinline__ float row8_sum(float s) { s = DPP_ADD(s, 0xB1); s = DPP_ADD(s, 0x4E); s = DPP_ADD(s, 0x141); return s; }
__device__ __forceinline__ float row16_sum(float s) { s = row8_sum(s); s = DPP_ADD(s, 0x140); return s; }
__device__ __forceinline__ float wave64_sum(float s) { s = row16_sum(s);
    return (__builtin_bit_cast(float, __builtin_amdgcn_readlane(__builtin_bit_cast(int, s), 0)) + __builtin_bit_cast(float, __builtin_amdgcn_readlane(__builtin_bit_cast(int, s), 16)))
         + (__builtin_bit_cast(float, __builtin_amdgcn_readlane(__builtin_bit_cast(int, s), 32)) + __builtin_bit_cast(float, __builtin_amdgcn_readlane(__builtin_bit_cast(int, s), 48))); }
#define XB_TMO      128
#define XB_XCNT(j)  (256  + 64 * (j))
#define XB_XSUB(j)  (1280 + 64 * (j))
#define XB_XGEN(j)  (2304 + 64 * (j))
#define XB_TOP      3328
#define XB_TOPGEN   3392
#define XCD_BAR_WORDS 3456
#define XB_SPIN_CAP (1u << 22)
__device__ __forceinline__ unsigned xb_ld(unsigned* p)              { return __hip_atomic_load(p, __ATOMIC_RELAXED, __HIP_MEMORY_SCOPE_AGENT); }
__device__ __forceinline__ unsigned xb_add(unsigned* p, unsigned v) { return __hip_atomic_fetch_add(p, v, __ATOMIC_RELAXED, __HIP_MEMORY_SCOPE_AGENT); }
__device__ __forceinline__ unsigned xb_xcc_id() { return (unsigned)__builtin_amdgcn_s_getreg((3 << 11) | 20) & 0xFu; }
#define XB_SPIN(cond, bar) do { unsigned _sp = 0; while (cond) { __builtin_amdgcn_s_sleep(1); \
    if ((++_sp & 255u) == 0u) { if (xb_ld(&(bar)[XB_TMO])) break; if (_sp > XB_SPIN_CAP) { atomicAdd(&(bar)[XB_TMO], 1u); break; } } } } while (0)
__device__ __forceinline__ void xcd_barrier_complete(unsigned* bar, unsigned x, unsigned& nloc, unsigned& nx) {
    const unsigned G = gridDim.x;
    unsigned sum, cnt, mine, sp = 0u;
    for (;;) {
        sum = 0u; cnt = 0u; mine = 0u;
#pragma unroll
        for (unsigned j = 0; j < 16; ++j) { const unsigned c = xb_ld(&bar[XB_XCNT(j)]); sum += c; cnt += (c > 0u) ? 1u : 0u; mine = (j == x) ? c : mine; }
        if (sum == G) break;
        __builtin_amdgcn_s_sleep(1);
        if ((++sp & 255u) == 0u) { if (xb_ld(&bar[XB_TMO])) break; if (sp > XB_SPIN_CAP) { atomicAdd(&bar[XB_TMO], 1u); break; } }
    }
    nloc = mine > 0u ? mine : 1u; nx = cnt > 0u ? cnt : 1u;
}
__device__ __forceinline__ void xcd_barrier(unsigned* bar, const unsigned x, volatile LAS unsigned* st) {
    asm volatile("s_waitcnt vmcnt(0)" ::: "memory");
    __syncthreads();
    if (threadIdx.x == 0) {
        __builtin_amdgcn_s_waitcnt(0);
        unsigned nloc = st[0], nx = st[1];
        if (nloc == 0u) { xcd_barrier_complete(bar, x, nloc, nx); st[0] = nloc; st[1] = nx; }
        const unsigned old = xb_add(&bar[XB_XSUB(x)], 1u);
        const unsigned gen = old / nloc;
        if (old + 1u == (gen + 1u) * nloc) {
            __builtin_amdgcn_fence(__ATOMIC_RELEASE, "agent");
            asm volatile("s_waitcnt vmcnt(0)" ::: "memory");
            const unsigned og = xb_add(&bar[XB_TOP], 1u);
            const unsigned tg = og / nx;
            if (og + 1u == (tg + 1u) * nx) xb_add(&bar[XB_TOPGEN], 1u);
            else XB_SPIN(xb_ld(&bar[XB_TOPGEN]) == tg, bar);
            __builtin_amdgcn_fence(__ATOMIC_ACQUIRE, "agent");
            xb_add(&bar[XB_XGEN(x)], 1u);
            asm volatile("s_waitcnt vmcnt(0)" ::: "memory");
        } else {
            XB_SPIN(xb_ld(&bar[XB_XGEN(x)]) == gen, bar);
            __builtin_amdgcn_fence(__ATOMIC_ACQUIRE, "agent");
            asm volatile("s_waitcnt vmcnt(0)" ::: "memory");
        }
    }
    __syncthreads();
}
#ifdef TS_SELECT
__device__ __forceinline__ void ts_mark(LAS unsigned char* lds, int cls) {
    if (blockIdx.x == TS_BLOCK && threadIdx.x == 0) { LAS unsigned* tw = (LAS unsigned*)(lds + LDS_CTL); const unsigned now = (unsigned)__builtin_amdgcn_s_memrealtime();
        tw[2 + cls] += now - tw[0]; tw[0] = now; }
}
#define PHC(c) ph_cls = (c)
#define TSM(c) ts_mark(lds, (c) >= 8 ? 7 : (c))
#else
#define PHC(c)
#define TSM(c)
#endif
#define MFMA16(a, b, c) __builtin_amdgcn_mfma_f32_16x16x32_bf16((a), (b), (c), 0, 0, 0)

namespace pg8 {
constexpr int BM = 256, BK = 64, HALF = 128, HTB = HALF * BK * 2, STAGE_BYTES = 8 * HTB, NXCD = 8, WGM = 8;
__host__ __device__ __forceinline__ int lds_byte(int r, int c) { const int st = (r >> 4) * 2 + (c >> 5), rr = r & 15, cc = c & 31, ob = rr * 64 + cc * 2; return st * 1024 + (ob ^ (((ob >> 9) & 1) << 5)); }
__host__ __device__ __forceinline__ void stage_rc(int b, int& R, int& C) { const int st = b / 1024, sb = b % 1024, swz = sb ^ (((sb >> 9) & 1) << 5); R = (st >> 1) * 16 + swz / 64; C = (st & 1) * 32 + (swz % 64) / 2; }
__host__ __device__ __forceinline__ int perm32(int rho) { const int n = rho >> 4, i = rho & 15; return 8 * (i >> 2) + 4 * n + (i & 3); }

struct Unit { int pm, pn, ka; };
struct Gemm { const bf16_t* A; const bf16_t* Bt; int M, N, K, lda; };

struct Order {
    int nM, nN, nwg, G, c, gates;
    __device__ void init(int M, int N, int G_, int c_, int gates_) { nM = M / BM; nN = N / BM; nwg = nM * nN; G = G_; c = c_; gates = gates_; }
    __device__ bool next(int i, Unit& u) const {
        const long L = (long)i * G + c; if (L >= nwg) return false;
        int wgid = (int)L; { const int q = nwg / NXCD, r = nwg % NXCD, xcd = wgid % NXCD, off = wgid / NXCD; wgid = (xcd < r ? xcd * (q + 1) : r * (q + 1) + (xcd - r) * q) + off; }
        const int nig = WGM * nN, gid = wgid / nig, fm = gid * WGM, gsz = (nM - fm) < WGM ? (nM - fm) : WGM;
        u.pm = fm + ((wgid % nig) % gsz); u.pn = (wgid % nig) / gsz; u.ka = gates ? (u.pn >> 1) * 256 : 0; return true;
    }
};

template <class Epi>
__device__ __forceinline__ void gemm_phase(LAS unsigned char* lds, const Gemm g, const Order& S, const Epi& E) {
    const int tid = tid_fresh(), wid = __builtin_amdgcn_readfirstlane(tid >> 6), lane = tid & 63, wr = wid >> 2, wc = wid & 3, fr = lane & 15, fq = lane >> 4;
    const int K = g.K, nt = K / BK;
    unsigned voffA[2], voffB[2];
#pragma unroll
    for (int i = 0; i < 2; ++i) { int R, C; stage_rc(tid * 16 + i * 8192, R, C); const int Rb = Epi::PERM ? ((R & ~31) + perm32(R & 31)) : R;
        voffA[i] = (unsigned)(R * g.lda + C) * 2u; voffB[i] = (unsigned)(Rb * K + C) * 2u; }
    const size_t kstep = (size_t)(BK * 2);
    const size_t hstepA = (size_t)HALF * g.lda * 2, hstepB = (size_t)HALF * K * 2;
    const size_t tstepA = 2 * hstepA, tstepB = 2 * hstepB;
    const unsigned ldsw = (unsigned)wid * 1024u;
    const int aoff = lds_byte(wr * 64 + fr, fq * 8), boff = lds_byte(wc * 32 + fr, fq * 8);
#define PG8_SA(b, h) (((b) * 2 + (h)) * HTB)
#define PG8_SB(b, h) ((4 + (b) * 2 + (h)) * HTB)
#define PG8_STAGE(bufoff, gbase, voff) do { _Pragma("unroll") for (int _i = 0; _i < 2; ++_i) \
        __builtin_amdgcn_global_load_lds((const unsigned*)((const char*)(gbase) + (voff)[_i]), (LAS unsigned*)(lds + (bufoff) + ldsw + _i * 8192), 16, 0, 0); } while (0)
#define PG8_LDA(dst, b, h) do { _Pragma("unroll") for (int m = 0; m < 4; ++m) _Pragma("unroll") for (int k = 0; k < 2; ++k) dst[m][k] = *(const LAS bf16x8*)(lds + PG8_SA(b, h) + aoff + m * 2048 + k * 1024); } while (0)
#define PG8_LDB(dst, b, h) do { _Pragma("unroll") for (int n = 0; n < 2; ++n) _Pragma("unroll") for (int k = 0; k < 2; ++k) dst[n][k] = *(const LAS bf16x8*)(lds + PG8_SB(b, h) + boff + n * 2048 + k * 1024); } while (0)
#define PG8_MMA(ai, bj, At, Bt) do { __builtin_amdgcn_s_setprio(1); _Pragma("unroll") for (int m = 0; m < 4; ++m) _Pragma("unroll") for (int n = 0; n < 2; ++n) _Pragma("unroll") for (int k = 0; k < 2; ++k) \
        acc[ai][bj][m][n] = __builtin_amdgcn_mfma_f32_16x16x32_bf16(Bt[n][k], At[m][k], acc[ai][bj][m][n], 0, 0, 0); __builtin_amdgcn_s_setprio(0); } while (0)
#define PG8_WAIT_V(n) asm volatile("s_waitcnt vmcnt(" #n ")" ::: "memory")
#define PG8_WAIT_L(n) asm volatile("s_waitcnt lgkmcnt(" #n ")" ::: "memory")
#define PG8_BAR __builtin_amdgcn_s_barrier()
#define PG8_SCHED __builtin_amdgcn_sched_barrier(0)
    Unit cur, nxt; int ui = 0;
    if (!S.next(0, cur)) return;
    f32x4 acc[2][2][4][2];
#pragma unroll
    for (int a = 0; a < 2; ++a)
#pragma unroll
        for (int b = 0; b < 2; ++b)
#pragma unroll
            for (int m = 0; m < 4; ++m)
#pragma unroll
                for (int n = 0; n < 2; ++n) acc[a][b][m][n] = (f32x4){0.f, 0.f, 0.f, 0.f};
    bf16x8 At[4][2], B0[2][2], B1[2][2];
    const char* cA = (const char*)g.A + (size_t)cur.pm * tstepA + (size_t)cur.ka * 2; const char* cB = (const char*)g.Bt + (size_t)cur.pn * tstepB;
    PG8_STAGE(PG8_SB(0, 0), cB, voffB); PG8_STAGE(PG8_SB(0, 1), cB + hstepB, voffB); PG8_STAGE(PG8_SA(0, 0), cA, voffA); PG8_STAGE(PG8_SA(0, 1), cA + hstepA, voffA);
    if (wr == 1) PG8_BAR;
    PG8_WAIT_V(2); PG8_BAR;
    PG8_STAGE(PG8_SB(1, 0), cB + kstep, voffB); PG8_STAGE(PG8_SA(1, 0), cA + kstep, voffA); PG8_STAGE(PG8_SB(1, 1), cB + hstepB + kstep, voffB);
    PG8_WAIT_V(6); PG8_BAR;
    for (;;) {
        const bool has_next = S.next(ui + 1, nxt);
        const char* nA = has_next ? (const char*)g.A + (size_t)nxt.pm * tstepA + (size_t)nxt.ka * 2 : cA; const char* nB = has_next ? (const char*)g.Bt + (size_t)nxt.pn * tstepB : cB;
        for (int t = 0; t < nt; t += 2) {
            const bool last = (t == nt - 2);
            const char* a1 = cA + (size_t)(t + 1) * kstep;
            const char* a2 = last ? nA : cA + (size_t)(t + 2) * kstep; const char* b2 = last ? nB : cB + (size_t)(t + 2) * kstep;
            const char* a3 = a2 + kstep; const char* b3 = b2 + kstep;
            PG8_LDB(B0, 0, 0); PG8_LDB(B1, 0, 1); PG8_SCHED; PG8_LDA(At, 0, 0); PG8_STAGE(PG8_SA(1, 1), a1 + hstepA, voffA);
            PG8_WAIT_V(8); PG8_WAIT_L(0); PG8_BAR; PG8_MMA(0, 0, At, B0); PG8_MMA(0, 1, At, B1); PG8_BAR; PG8_SCHED;
            PG8_LDA(At, 0, 1); PG8_STAGE(PG8_SB(0, 0), b2, voffB); PG8_STAGE(PG8_SB(0, 1), b2 + hstepB, voffB); PG8_STAGE(PG8_SA(0, 0), a2, voffA);
            PG8_WAIT_V(8); PG8_WAIT_L(0); PG8_BAR; PG8_MMA(1, 0, At, B0); PG8_MMA(1, 1, At, B1); PG8_BAR; PG8_SCHED;
            PG8_LDB(B0, 1, 0); PG8_LDB(B1, 1, 1); PG8_SCHED; PG8_LDA(At, 1, 0); PG8_STAGE(PG8_SA(0, 1), a2 + hstepA, voffA);
            PG8_WAIT_V(8); PG8_WAIT_L(0); PG8_BAR; PG8_MMA(0, 0, At, B0); PG8_MMA(0, 1, At, B1); PG8_BAR; PG8_SCHED;
            PG8_LDA(At, 1, 1); PG8_STAGE(PG8_SB(1, 0), b3, voffB); PG8_STAGE(PG8_SB(1, 1), b3 + hstepB, voffB); PG8_STAGE(PG8_SA(1, 0), a3, voffA);
            PG8_WAIT_V(8); PG8_WAIT_L(0); PG8_BAR; PG8_MMA(1, 0, At, B0); PG8_MMA(1, 1, At, B1); PG8_BAR; PG8_SCHED;
        }
        if (wr == 0) PG8_BAR;
        E(acc, cur, wr, wc, fr, fq);
        if (!has_next) break;
#pragma unroll
        for (int a = 0; a < 2; ++a)
#pragma unroll
            for (int b = 0; b < 2; ++b)
#pragma unroll
                for (int m = 0; m < 4; ++m)
#pragma unroll
                    for (int n = 0; n < 2; ++n) acc[a][b][m][n] = (f32x4){0.f, 0.f, 0.f, 0.f};
        cur = nxt; cA = nA; cB = nB; ++ui;
        if (wr == 1) PG8_BAR;
    }
    PG8_WAIT_V(0);
    PG8_BAR;
#undef PG8_SA
#undef PG8_SB
#undef PG8_STAGE
#undef PG8_LDA
#undef PG8_LDB
#undef PG8_MMA
#undef PG8_WAIT_V
#undef PG8_WAIT_L
#undef PG8_BAR
#undef PG8_SCHED
}

typedef const f32x4 (&AccRef)[2][2][4][2];
template <int ACT> struct EpiBf16 {
    static constexpr bool PERM = true;
    bf16_t* O; int ldc;
    __device__ __forceinline__ void operator()(AccRef acc, const Unit& u, int wr, int wc, int fr, int fq) const {
        const int row0 = u.pm * BM + wr * 64 + fr, col0 = u.pn * BM + wc * 32 + 8 * fq;
#pragma unroll
        for (int ai = 0; ai < 2; ++ai)
#pragma unroll
            for (int m = 0; m < 4; ++m) { bf16_t* rowp = O + (size_t)(row0 + ai * HALF + m * 16) * ldc + col0;
#pragma unroll
                for (int bj = 0; bj < 2; ++bj) { f32x4 v0 = acc[ai][bj][m][0], v1 = acc[ai][bj][m][1];
                    if (ACT == 1) {
#pragma unroll
                        for (int j = 0; j < 4; ++j) { const float a = fmaxf(v0[j], 0.f), b = fmaxf(v1[j], 0.f); v0[j] = a * a; v1[j] = b * b; } }
                    u32x4 w; w.x = cvt_pk_bf16(v0[0], v0[1]); w.y = cvt_pk_bf16(v0[2], v0[3]); w.z = cvt_pk_bf16(v1[0], v1[1]); w.w = cvt_pk_bf16(v1[2], v1[3]);
                    *(u32x4*)(rowp + bj * HALF) = w; } }
    }
};
struct EpiProjHyb {
    static constexpr bool PERM = true;
    bf16_t* O; float* BL;
    __device__ __forceinline__ void operator()(AccRef acc, const Unit& u, int wr, int wc, int fr, int fq) const {
        const int row0 = u.pm * BM + wr * 64 + fr;
        if (u.pn == 11) {
            if (wc == 0 && fq == 0) {
#pragma unroll
                for (int ai = 0; ai < 2; ++ai)
#pragma unroll
                    for (int m = 0; m < 4; ++m) { float* bp = BL + (size_t)(row0 + ai * HALF + m * 16) * 8; *(f32x4*)bp = acc[ai][0][m][0]; *(f32x4*)(bp + 4) = acc[ai][0][m][1]; }
            }
            return;
        }
        const int col0 = u.pn * BM + wc * 32 + 8 * fq;
#pragma unroll
        for (int ai = 0; ai < 2; ++ai)
#pragma unroll
            for (int m = 0; m < 4; ++m) { bf16_t* rowp = O + (size_t)(row0 + ai * HALF + m * 16) * HPP + col0;
#pragma unroll
                for (int bj = 0; bj < 2; ++bj) { const f32x4 v0 = acc[ai][bj][m][0], v1 = acc[ai][bj][m][1];
                    u32x4 w; w.x = cvt_pk_bf16(v0[0], v0[1]); w.y = cvt_pk_bf16(v0[2], v0[3]); w.z = cvt_pk_bf16(v1[0], v1[1]); w.w = cvt_pk_bf16(v1[2], v1[3]);
                    *(u32x4*)(rowp + bj * HALF) = w; } }
    }
};
struct EpiResid {
    static constexpr bool PERM = true;
    const bf16_t* XB; bf16_t* Y;
    __device__ __forceinline__ void operator()(AccRef acc, const Unit& u, int wr, int wc, int fr, int fq) const {
        const int row0 = u.pm * BM + wr * 64 + fr, col0 = u.pn * BM + wc * 32 + 8 * fq;
#pragma unroll
        for (int ai = 0; ai < 2; ++ai)
#pragma unroll
            for (int m = 0; m < 4; ++m) { const size_t off = (size_t)(row0 + ai * HALF + m * 16) * DM + col0;
#pragma unroll
                for (int bj = 0; bj < 2; ++bj) { const size_t o = off + bj * HALF; const u32x4 xv = *(const u32x4*)(XB + o);
                    const f32x4 a0 = acc[ai][bj][m][0], a1 = acc[ai][bj][m][1];
                    u32x4 w;
                    w.x = cvt_pk_bf16(DN_ALPHA * bflo(xv.x) + a0[0], DN_ALPHA * bfhi(xv.x) + a0[1]); w.y = cvt_pk_bf16(DN_ALPHA * bflo(xv.y) + a0[2], DN_ALPHA * bfhi(xv.y) + a0[3]);
                    w.z = cvt_pk_bf16(DN_ALPHA * bflo(xv.z) + a1[0], DN_ALPHA * bfhi(xv.z) + a1[1]); w.w = cvt_pk_bf16(DN_ALPHA * bflo(xv.w) + a1[2], DN_ALPHA * bfhi(xv.w) + a1[3]);
                    *(u32x4*)(Y + o) = w; } }
    }
};
}

__device__ __forceinline__ void transpose_tile(const float* __restrict__ src, int ld, int K, int Nvalid, bf16_t* __restrict__ dst, int k0, int n0, LAS float* tile, const int tid) {
    { const int n = tid & 63, kk = tid >> 6;
#pragma unroll
      for (int i = 0; i < 8; ++i) { const int k = kk + 8 * i; tile[k * 65 + n] = (n0 + n < Nvalid) ? src[(size_t)(k0 + k) * ld + n0 + n] : 0.f; } }
    __syncthreads();
    { const int k2 = (tid & 31) * 2, nn = tid >> 5;
#pragma unroll
      for (int i = 0; i < 4; ++i) { const int n = nn + 16 * i; *(unsigned*)(dst + (size_t)(n0 + n) * K + k0 + k2) = cvt_pk_bf16(tile[k2 * 65 + n], tile[(k2 + 1) * 65 + n]); } }
    __syncthreads();
}

__device__ __forceinline__ void prep_phase(LAS unsigned char* lds) {
    const Params p = load_params();
    const int tid = tid_fresh(), G = gridDim.x;
    const size_t gtid = (size_t)blockIdx.x * 512 + tid, gsz = (size_t)G * 512;
    {
        const f32x4* src = (const f32x4*)p.x; u32x2* dst = (u32x2*)(p.ws + OFF_XB);
        const size_t n4 = (size_t)MTOK * DM / 4;
        for (size_t i = gtid; i < n4; i += gsz) { const f32x4 v = src[i]; u32x2 w; w.x = cvt_pk_bf16(v[0], v[1]); w.y = cvt_pk_bf16(v[2], v[3]); dst[i] = w; }
    }
    {
        float* rope = (float*)(p.ws + OFF_ROPE);
        for (size_t i = gtid; i < (size_t)SEQ * 32; i += gsz) { const int t = (int)(i >> 5), j = (int)(i & 31);
            const float inv = (float)exp(-(double)j * (9.210340371976184 / 32.0)); const float ang = (float)t * inv;
            double s, c; sincos((double)ang, &s, &c); rope[i * 2] = (float)c; rope[i * 2 + 1] = (float)s; }
    }
    LAS float* tile = (LAS float*)lds;
    int base = 0;
    for (int j = 0; j < 17; ++j) {
        const float* src = nullptr; bf16_t* dst = nullptr; int ld = 0, K = 0, N = 0, Np = 0, ntiles;
        if (j < 2) { src = p.hyb_w_in + (size_t)j * 1024 * 2824; ld = 2824; K = 1024; N = 2824; Np = 3072; dst = (bf16_t*)(p.ws + WB_HIN) + (size_t)j * 3072 * 1024; }
        else if (j < 4) { const int l = j - 2; src = p.hyb_w_out + (size_t)l * 1024 * 1024; ld = 1024; K = 1024; N = 1024; Np = 1024; dst = (bf16_t*)(p.ws + WB_HOUT) + (size_t)l * 1024 * 1024; }
        else if (j < 6) { const int l = j - 4; src = p.rec_w_in + (size_t)l * 1024 * 2048; ld = 2048; K = 1024; N = 2048; Np = 2048; dst = (bf16_t*)(p.ws + WB_RIN) + (size_t)l * 2048 * 1024; }
        else if (j < 8) { const int l = j - 6; src = p.rec_w_out + (size_t)l * 1024 * 1024; ld = 1024; K = 1024; N = 1024; Np = 1024; dst = (bf16_t*)(p.ws + WB_ROUT) + (size_t)l * 1024 * 1024; }
        else if (j < 12) { const int l = j - 8; src = p.mlp_w1 + (size_t)l * 1024 * 4096; ld = 4096; K = 1024; N = 4096; Np = 4096; dst = (bf16_t*)(p.ws + WB_W1) + (size_t)l * 4096 * 1024; }
        else if (j < 16) { const int l = j - 12; src = p.mlp_w2 + (size_t)l * 4096 * 1024; ld = 1024; K = 4096; N = 1024; Np = 1024; dst = (bf16_t*)(p.ws + WB_W2) + (size_t)l * 1024 * 4096; }
        ntiles = (j < 16) ? (K / 64) * (Np / 64) : 256;
        for (int t = ((int)blockIdx.x - base % G + G) % G; t < ntiles; t += G) {
            if (j < 16) { const int kt = t % (K / 64), ntl = t / (K / 64); transpose_tile(src, ld, K, N, dst, kt * 64, ntl * 64, tile, tid); }
            else {
                const int idx = t >> 3, sub = t & 7, kt = sub & 3, ntl = sub >> 2, l = idx >> 4, pn = (idx >> 1) & 7, gg = idx & 1, h = pn >> 1, hh = pn & 1;
                const float* s2 = (gg ? p.rec_w_x : p.rec_w_a) + (size_t)l * 4 * 65536 + (size_t)h * 65536 + hh * 128;
                bf16_t* d2 = (bf16_t*)(p.ws + WB_RG) + (size_t)l * 2048 * 256 + (size_t)(pn * 256 + gg * 128) * 256;
                transpose_tile(s2, 256, 256, 128, d2, kt * 64, ntl * 64, tile, tid);
            }
        }
        base += ntiles;
    }
}

__device__ __forceinline__ void ln_phase(const bf16_t* Y, const float* __restrict__ g, const float* __restrict__ b, bf16_t* xb, float* outf) {
    const int tid = tid_fresh(); const int wave = tid >> 6, lane = tid & 63;
    f32x4 gv[4], bv[4];
#pragma unroll
    for (int j = 0; j < 2; ++j) { gv[2 * j] = *(const f32x4*)(g + j * 512 + lane * 8); gv[2 * j + 1] = *(const f32x4*)(g + j * 512 + lane * 8 + 4);
        bv[2 * j] = *(const f32x4*)(b + j * 512 + lane * 8); bv[2 * j + 1] = *(const f32x4*)(b + j * 512 + lane * 8 + 4); }
    const int nw = gridDim.x * 8;
    for (int row0 = blockIdx.x * 8 + wave; row0 < MTOK; row0 += 2 * nw) {
        u32x4 raw[2][2];
#pragma unroll
        for (int r = 0; r < 2; ++r) { const bf16_t* yr = Y + (size_t)(row0 + r * nw) * DM;
#pragma unroll
            for (int j = 0; j < 2; ++j) raw[r][j] = *(const u32x4*)(yr + j * 512 + lane * 8); }
#pragma unroll
        for (int r = 0; r < 2; ++r) {
            const int row = row0 + r * nw;
            f32x4 v[4];
#pragma unroll
            for (int j = 0; j < 2; ++j) { const u32x4 q = raw[r][j]; v[2 * j] = (f32x4){bflo(q.x), bfhi(q.x), bflo(q.y), bfhi(q.y)}; v[2 * j + 1] = (f32x4){bflo(q.z), bfhi(q.z), bflo(q.w), bfhi(q.w)}; }
            float s = 0.f;
#pragma unroll
            for (int j = 0; j < 4; ++j) s += (v[j][0] + v[j][1]) + (v[j][2] + v[j][3]);
            s = wave64_sum(s);
            const float mean = s * (1.0f / 1024.0f);
            float q = 0.f;
#pragma unroll
            for (int j = 0; j < 4; ++j) { const f32x4 d = v[j] - mean; q += (d[0] * d[0] + d[1] * d[1]) + (d[2] * d[2] + d[3] * d[3]); }
            q = wave64_sum(q);
            const float rstd = rsqrtf(q * (1.0f / 1024.0f) + 1e-5f);
            f32x4 o[4];
#pragma unroll
            for (int j = 0; j < 4; ++j) o[j] = (v[j] - mean) * rstd * gv[j] + bv[j];
#pragma unroll
            for (int j = 0; j < 2; ++j) {
                if (outf) { float* op = outf + (size_t)row * DM + j * 512 + lane * 8; *(f32x4*)op = o[2 * j]; *(f32x4*)(op + 4) = o[2 * j + 1]; }
                else { u32x4 w; w.x = cvt_pk_bf16(o[2 * j][0], o[2 * j][1]); w.y = cvt_pk_bf16(o[2 * j][2], o[2 * j][3]); w.z = cvt_pk_bf16(o[2 * j + 1][0], o[2 * j + 1][1]); w.w = cvt_pk_bf16(o[2 * j + 1][2], o[2 * j + 1][3]);
                    *(u32x4*)(xb + (size_t)row * DM + j * 512 + lane * 8) = w; } }
        }
    }
}

__device__ __forceinline__ void rconv_phase(const bf16_t* proj2, const float* __restrict__ cw, const float* __restrict__ cb, bf16_t* xrc) {
    const int tid = tid_fresh();
    for (int it = blockIdx.x * 512 + tid; it < 131072; it += gridDim.x * 512) {
        const int cgp = it & 127, seg = (it >> 7) & 127, b = it >> 14, c0 = cgp * 8, t0 = seg * 32;
        float w[4][8], bias[8], xw[3][8];
#pragma unroll
        for (int j = 0; j < 4; ++j) { const f32x4 a = *(const f32x4*)(cw + j * 1024 + c0), c = *(const f32x4*)(cw + j * 1024 + c0 + 4);
#pragma unroll
            for (int d = 0; d < 4; ++d) { w[j][d] = a[d]; w[j][4 + d] = c[d]; } }
        { const f32x4 a = *(const f32x4*)(cb + c0), c = *(const f32x4*)(cb + c0 + 4);
#pragma unroll
          for (int d = 0; d < 4; ++d) { bias[d] = a[d]; bias[4 + d] = c[d]; } }
#pragma unroll
        for (int j = 0; j < 3; ++j) { const int t = t0 - 3 + j;
            u32x4 v = (u32x4){0u, 0u, 0u, 0u};
            if (t >= 0) v = *(const u32x4*)(proj2 + (size_t)(b * SEQ + t) * 2048 + c0);
            xw[j][0] = bflo(v.x); xw[j][1] = bfhi(v.x); xw[j][2] = bflo(v.y); xw[j][3] = bfhi(v.y); xw[j][4] = bflo(v.z); xw[j][5] = bfhi(v.z); xw[j][6] = bflo(v.w); xw[j][7] = bfhi(v.w); }
#pragma unroll 4
        for (int t = 0; t < 32; ++t) {
            const u32x4 v = *(const u32x4*)(proj2 + (size_t)(b * SEQ + t0 + t) * 2048 + c0);
            const float x3[8] = {bflo(v.x), bfhi(v.x), bflo(v.y), bfhi(v.y), bflo(v.z), bfhi(v.z), bflo(v.w), bfhi(v.w)};
            float y[8];
#pragma unroll
            for (int d = 0; d < 8; ++d) { y[d] = bias[d] + w[0][d] * xw[0][d] + w[1][d] * xw[1][d] + w[2][d] * xw[2][d] + w[3][d] * x3[d]; xw[0][d] = xw[1][d]; xw[1][d] = xw[2][d]; xw[2][d] = x3[d]; }
            u32x4 o; o.x = cvt_pk_bf16(y[0], y[1]); o.y = cvt_pk_bf16(y[2], y[3]); o.z = cvt_pk_bf16(y[4], y[5]); o.w = cvt_pk_bf16(y[6], y[7]);
            *(u32x4*)(xrc + (size_t)(b * SEQ + t0 + t) * DM + c0) = o;
        }
    }
}
__device__ __forceinline__ void lru_ab(float ra, float ix, float x, float sp, float& a, float& b, float& l) {
    const float r = sigmoidf_(ra), ig = sigmoidf_(ix); l = r * sp; const float x2 = 2.0f * l;
    a = __expf(l);
    const float om = (x2 > -0.25f) ? -x2 * (1.0f + x2 * (0.5f + x2 * (0.16666667f + x2 * (0.041666668f + x2 * (0.0083333333f + x2 * 0.0013888889f))))) : 1.0f - a * a;
    b = sqrtf(fmaxf(om, 0.f)) * (ig * x);
}
__device__ __forceinline__ float softplus_neg8(float lm) { const float e = __expf(-lm); const float l1 = (e < 0.03f) ? e * (1.0f - e * (0.5f - e * (0.33333333f - 0.25f * e))) : __logf(1.0f + e); return -8.0f * l1; }
__device__ __forceinline__ float gelu_tanh(float x) { const float u = 0.7978845608028654f * (x + 0.044715f * x * x * x); const float t = 1.0f - 2.0f / (1.0f + __expf(2.0f * u)); return 0.5f * x * (1.0f + t); }
template <int PASS>
__device__ __forceinline__ void rscan_phase(const bf16_t* GB, const bf16_t* xrc, const float* __restrict__ b_a, const float* __restrict__ b_x, const float* __restrict__ lam, float* CLA, float* CH, bf16_t* proj2, unsigned* LB) {
    const int tid = tid_fresh();
    for (int it = blockIdx.x * 512 + tid; it < 8 * 64 * 512; it += gridDim.x * 512) {
        const int cp = it & 511, seg = (it >> 9) & 63, b = it >> 15, c = 2 * cp, gcol = (c >> 7) * 256 + (c & 127);
        float h0 = 0.f, h1 = 0.f, sl0 = 0.f, sl1 = 0.f;
        const size_t row0 = (size_t)(b * SEQ + seg * 64);
        if (PASS == 1) {
            const float ba0 = b_a[c], ba1 = b_a[c + 1], bx0 = b_x[c], bx1 = b_x[c + 1], sp0 = softplus_neg8(lam[c]), sp1 = softplus_neg8(lam[c + 1]);
            for (int t0 = 0; t0 < 64; t0 += 8) {
                unsigned ga[8], gx[8], xv[8];
#pragma unroll
                for (int t = 0; t < 8; ++t) { const size_t row = row0 + t0 + t;
                    ga[t] = *(const unsigned*)(GB + row * 2048 + gcol); gx[t] = *(const unsigned*)(GB + row * 2048 + gcol + 128); xv[t] = *(const unsigned*)(xrc + row * DM + c); }
#pragma unroll
                for (int t = 0; t < 8; ++t) { float a0, b0, a1, b1, l0, l1;
                    lru_ab(bflo(ga[t]) + ba0, bflo(gx[t]) + bx0, bflo(xv[t]), sp0, a0, b0, l0);
                    lru_ab(bfhi(ga[t]) + ba1, bfhi(gx[t]) + bx1, bfhi(xv[t]), sp1, a1, b1, l1);
                    const unsigned w0 = cvt_pk_bf16(l0, b0), w1 = cvt_pk_bf16(l1, b1);
                    *(u32x2*)(LB + (row0 + t0 + t) * DM + c) = (u32x2){w0, w1};
                    const float lr0 = bflo(w0), lr1 = bflo(w1);
                    h0 = __expf(lr0) * h0 + bfhi(w0); h1 = __expf(lr1) * h1 + bfhi(w1); sl0 += lr0; sl1 += lr1; }
            }
            const int ci = (b * 64 + seg) * 1024 + c; *(f32x2*)(CLA + ci) = (f32x2){sl0, sl1}; *(f32x2*)(CH + ci) = (f32x2){h0, h1};
        } else {
            for (int s0 = 0; s0 < seg; s0 += 8) {
                f32x2 la[8], hh[8];
#pragma unroll
                for (int k = 0; k < 8; ++k) { const int sk = (s0 + k < seg) ? s0 + k : seg - 1; const int ci = (b * 64 + sk) * 1024 + c; la[k] = *(const f32x2*)(CLA + ci); hh[k] = *(const f32x2*)(CH + ci); }
#pragma unroll
                for (int k = 0; k < 8; ++k) if (s0 + k < seg) { h0 = __expf(la[k][0]) * h0 + hh[k][0]; h1 = __expf(la[k][1]) * h1 + hh[k][1]; }
            }
            for (int t0 = 0; t0 < 64; t0 += 8) {
                u32x2 lb[8]; unsigned gt[8];
#pragma unroll
                for (int t = 0; t < 8; ++t) { const size_t row = row0 + t0 + t; lb[t] = *(const u32x2*)(LB + row * DM + c); gt[t] = *(const unsigned*)(proj2 + row * 2048 + 1024 + c); }
#pragma unroll
                for (int t = 0; t < 8; ++t) {
                    h0 = __expf(bflo(lb[t].x)) * h0 + bfhi(lb[t].x); h1 = __expf(bflo(lb[t].y)) * h1 + bfhi(lb[t].y);
                    *(unsigned*)(proj2 + (row0 + t0 + t) * 2048 + c) = cvt_pk_bf16(h0 * gelu_tanh(bflo(gt[t])), h1 * gelu_tanh(bfhi(gt[t]))); }
            }
        }
    }
}

__device__ __forceinline__ void dn_local_phase(LAS unsigned char* lds, int lj, const int n_lo, const int n_cnt, const int pb, const int npb) {
    const Params p = load_params();
    const int tid = tid_fresh(), wid = tid >> 6, lane = tid & 63, fr = lane & 15, fq = lane >> 4;
    const bf16_t* proj = (const bf16_t*)(p.ws + S_PROJ); const float* BL = (const float*)(p.ws + S_BL);
    bf16_t* QGg = (bf16_t*)(p.ws + S_QG); bf16_t* KTg = (bf16_t*)(p.ws + S_KT); bf16_t* Wg = (bf16_t*)(p.ws + S_W); bf16_t* QKg = (bf16_t*)(p.ws + S_QK);
    float* GLg = (float*)(p.ws + S_GL); float* Ug = p.out;
    const float* cw = p.hyb_conv_w + (size_t)lj * 4 * 1536;
    LAS unsigned char* Kb = lds + 16896; LAS unsigned char* Qb = lds + 34304;
    LAS float* RHS = (LAS float*)(lds + 51712); LAS float* AM = (LAS float*)lds; LAS float* Gs = (LAS float*)(lds + 16384); LAS float* Bs = (LAS float*)(lds + 16640);
    for (int idx = pb; idx < 32 * n_cnt; idx += npb) {
        const int it = (idx & 31) * 64 + n_lo + (idx >> 5);
        const int n = it & 63, h = (it >> 6) & 3, b = it >> 8;
        const int rowbase = b * SEQ + n * 64;
        if (wid == 0) {
            const float bl = BL[(size_t)(rowbase + lane) * 8 + h], al = BL[(size_t)(rowbase + lane) * 8 + 4 + h];
            const float beta = sigmoidf_(bl); const float xx = al + p.hyb_dt_bias[lj * 4 + h];
            const float sp = xx > 20.f ? xx : log1pf(__expf(xx));
            float g = -__expf(p.hyb_a_log[lj * 4 + h]) * sp;
#pragma unroll
            for (int o = 1; o < 64; o <<= 1) { const float t = __shfl_up(g, o); if (lane >= o) g += t; }
            Gs[lane] = g; Bs[lane] = beta;
            if (lane == 63) GLg[it] = g;
        }
        __syncthreads();
        {
            const int r = tid >> 3, sub = tid & 7, t = n * 64 + r;
            float y[3][16];
#pragma unroll
            for (int part = 0; part < 3; ++part) {
                const int col0 = 768 + part * 512 + h * 128 + sub * 16, c0 = part * 512 + h * 128 + sub * 16;
#pragma unroll
                for (int d = 0; d < 16; ++d) y[part][d] = 0.f;
#pragma unroll
                for (int j = 0; j < 4; ++j) { const int tt = t - 3 + j;
                    if (tt >= 0) { const bf16_t* xp = proj + (size_t)(b * SEQ + tt) * HPP + col0; const u32x4 v0 = *(const u32x4*)xp, v1 = *(const u32x4*)(xp + 8);
                        const float xs[16] = {bflo(v0.x), bfhi(v0.x), bflo(v0.y), bfhi(v0.y), bflo(v0.z), bfhi(v0.z), bflo(v0.w), bfhi(v0.w), bflo(v1.x), bfhi(v1.x), bflo(v1.y), bfhi(v1.y), bflo(v1.z), bfhi(v1.z), bflo(v1.w), bfhi(v1.w)};
                        const float* wp = cw + j * 1536 + c0;
#pragma unroll
                        for (int d4 = 0; d4 < 4; ++d4) { const f32x4 wv = *(const f32x4*)(wp + d4 * 4);
#pragma unroll
                            for (int e = 0; e < 4; ++e) y[part][d4 * 4 + e] += wv[e] * xs[d4 * 4 + e]; } } }
#pragma unroll
                for (int d = 0; d < 16; ++d) y[part][d] = y[part][d] * sigmoidf_(y[part][d]);
            }
            float sq = 0.f, sk = 0.f;
#pragma unroll
            for (int d = 0; d < 16; ++d) { sq += y[0][d] * y[0][d]; sk += y[1][d] * y[1][d]; }
            sq = row8_sum(sq); sk = row8_sum(sk);
            const float rq = rsqrtf(sq + 1e-6f) * 0.08838834764831845f, rk = rsqrtf(sk + 1e-6f);
            const float Gr = Gs[r], Gl = Gs[63], eg = __expf(Gr), et = __expf(Gl - Gr), beta = Bs[r];
            float qn[16], kn[16];
#pragma unroll
            for (int d = 0; d < 16; ++d) { qn[d] = y[0][d] * rq; kn[d] = y[1][d] * rk; }
            { u32x4 a, c;
              a.x = cvt_pk_bf16(qn[0], qn[1]); a.y = cvt_pk_bf16(qn[2], qn[3]); a.z = cvt_pk_bf16(qn[4], qn[5]); a.w = cvt_pk_bf16(qn[6], qn[7]);
              c.x = cvt_pk_bf16(qn[8], qn[9]); c.y = cvt_pk_bf16(qn[10], qn[11]); c.z = cvt_pk_bf16(qn[12], qn[13]); c.w = cvt_pk_bf16(qn[14], qn[15]);
              *(LAS u32x4*)(Qb + r * 272 + sub * 32) = a; *(LAS u32x4*)(Qb + r * 272 + sub * 32 + 16) = c;
              a.x = cvt_pk_bf16(kn[0], kn[1]); a.y = cvt_pk_bf16(kn[2], kn[3]); a.z = cvt_pk_bf16(kn[4], kn[5]); a.w = cvt_pk_bf16(kn[6], kn[7]);
              c.x = cvt_pk_bf16(kn[8], kn[9]); c.y = cvt_pk_bf16(kn[10], kn[11]); c.z = cvt_pk_bf16(kn[12], kn[13]); c.w = cvt_pk_bf16(kn[14], kn[15]);
              *(LAS u32x4*)(Kb + r * 272 + sub * 32) = a; *(LAS u32x4*)(Kb + r * 272 + sub * 32 + 16) = c;
              a.x = cvt_pk_bf16(qn[0] * eg, qn[1] * eg); a.y = cvt_pk_bf16(qn[2] * eg, qn[3] * eg); a.z = cvt_pk_bf16(qn[4] * eg, qn[5] * eg); a.w = cvt_pk_bf16(qn[6] * eg, qn[7] * eg);
              c.x = cvt_pk_bf16(qn[8] * eg, qn[9] * eg); c.y = cvt_pk_bf16(qn[10] * eg, qn[11] * eg); c.z = cvt_pk_bf16(qn[12] * eg, qn[13] * eg); c.w = cvt_pk_bf16(qn[14] * eg, qn[15] * eg);
              bf16_t* qp = QGg + (size_t)it * 8192 + r * 128 + sub * 16; *(u32x4*)qp = a; *(u32x4*)(qp + 8) = c; }
            bf16_t* ktp = KTg + (size_t)it * 8192;
#pragma unroll
            for (int d = 0; d < 16; ++d) {
                RHS[r * 256 + sub * 16 + d] = y[2][d] * beta;
                RHS[r * 256 + 128 + sub * 16 + d] = kn[d] * beta * eg;
                ktp[(sub * 16 + d) * 64 + r] = f2bf(kn[d] * et);
            }
        }
        __syncthreads();
        {
            const int ti = wid >> 1, isqk = wid & 1;
            LAS unsigned char* Xb = isqk ? Qb : Kb;
            bf16_t* qkp = QKg + (size_t)it * 4096;
#pragma unroll
            for (int tj = 0; tj < 4; ++tj) {
                if (tj <= ti) {
                    f32x4 acc = (f32x4){0.f, 0.f, 0.f, 0.f};
#pragma unroll
                    for (int ks = 0; ks < 4; ++ks) {
                        const bf16x8 a = *(LAS bf16x8*)(Xb + (ti * 16 + fr) * 272 + ks * 64 + fq * 16);
                        const bf16x8 bb = *(LAS bf16x8*)(Kb + (tj * 16 + fr) * 272 + ks * 64 + fq * 16);
                        acc = MFMA16(a, bb, acc);
                    }
                    const int j = tj * 16 + fr; const float Gj = Gs[j];
#pragma unroll
                    for (int e = 0; e < 4; ++e) { const int i = ti * 16 + 4 * fq + e; const float dec = __expf(fminf(Gs[i] - Gj, 0.f));
                        if (isqk) qkp[i * 64 + j] = (i >= j) ? f2bf(acc[e] * dec) : (bf16_t)0;
                        else AM[i * 64 + j] = (i > j) ? Bs[i] * acc[e] * dec : 0.f; }
                } else if (isqk) {
                    const int j = tj * 16 + fr;
#pragma unroll
                    for (int e = 0; e < 4; ++e) qkp[(ti * 16 + 4 * fq + e) * 64 + j] = (bf16_t)0;
                }
            }
        }
        __syncthreads();
        if (tid < 256) {
            const int c = tid;
            LAS float* RHSc = RHS + c;
            float X[64];
#pragma unroll
            for (int i = 0; i < 64; ++i) {
                float a0 = RHSc[i * 256], a1 = 0.f, a2 = 0.f, a3 = 0.f;
#pragma unroll
                for (int j4 = 0; j4 < (i + 3) / 4; ++j4) {
                    const f32x4 av = *(LAS f32x4*)(AM + i * 64 + j4 * 4);
                    if (j4 * 4 + 0 < i) a0 -= av[0] * X[j4 * 4 + 0];
                    if (j4 * 4 + 1 < i) a1 -= av[1] * X[j4 * 4 + 1];
                    if (j4 * 4 + 2 < i) a2 -= av[2] * X[j4 * 4 + 2];
                    if (j4 * 4 + 3 < i) a3 -= av[3] * X[j4 * 4 + 3];
                }
                X[i] = (a0 + a1) + (a2 + a3);
            }
            if (c < 128) {
                float* up = Ug + (size_t)it * 8192; const int slice = c >> 4, nn = c & 15;
#pragma unroll
                for (int mt = 0; mt < 4; ++mt)
#pragma unroll
                    for (int qq = 0; qq < 4; ++qq) { const int i0 = mt * 16 + qq * 4;
                        *(f32x4*)(up + ((slice * 4 + mt) * 64 + qq * 16 + nn) * 4) = (f32x4){X[i0], X[i0 + 1], X[i0 + 2], X[i0 + 3]}; }
            } else {
                bf16_t* wp = Wg + (size_t)it * 8192 + (c - 128);
#pragma unroll
                for (int i = 0; i < 64; ++i) wp[i * 128] = f2bf(X[i]);
            }
        }
        __syncthreads();
    }
}

__device__ __forceinline__ void dn_scan_chain(LAS unsigned char* lds, int lj, int chain, unsigned* half_cnt, const unsigned half_need) {
    const Params p = load_params();
    const int tid = tid_fresh(), w = __builtin_amdgcn_readfirstlane(tid >> 6), lane = tid & 63, fr = lane & 15, fq = lane >> 4;
    const int b = chain >> 2, h = chain & 3;
    const bf16_t* QGg = (const bf16_t*)(p.ws + S_QG); const bf16_t* KTg = (const bf16_t*)(p.ws + S_KT); const bf16_t* Wg = (const bf16_t*)(p.ws + S_W); const bf16_t* QKg = (const bf16_t*)(p.ws + S_QK);
    const float* GLg = (const float*)(p.ws + S_GL); const float* Ug = p.out;
    bf16_t* ORAW = (bf16_t*)(p.out + (size_t)16 * 1024 * 1024);
    f32x4 S[8];
#pragma unroll
    for (int i = 0; i < 8; ++i) S[i] = (f32x4){0.f, 0.f, 0.f, 0.f};
    u32x4 st[7]; f32x4 unext[4];
#define DN_WRITE(bufb) do { LAS unsigned char* _b = lds + (bufb); \
        _Pragma("unroll") for (int i = 0; i < 2; ++i) { const int q = tid + 512 * i; \
            *(LAS u32x4*)(_b + (q >> 4) * 272 + (q & 15) * 16) = st[i]; \
            *(LAS u32x4*)(_b + 17408 + (q >> 4) * 272 + (q & 15) * 16) = st[2 + i]; \
            *(LAS u32x4*)(_b + 34816 + (q >> 3) * 144 + (q & 7) * 16) = st[4 + i]; } \
        *(LAS u32x4*)(_b + 53248 + (tid >> 3) * 144 + (tid & 7) * 16) = st[6]; } while (0)
#define DN_ISSUE_ST(it_) do { const size_t _it = (size_t)(it_); \
        const u32x4* gW = (const u32x4*)(Wg + _it * 8192); const u32x4* gQ = (const u32x4*)(QGg + _it * 8192); const u32x4* gK = (const u32x4*)(KTg + _it * 8192); const u32x4* gP = (const u32x4*)(QKg + _it * 4096); \
        st[0] = gW[tid]; st[1] = gW[tid + 512]; st[2] = gQ[tid]; st[3] = gQ[tid + 512]; st[4] = gK[tid]; st[5] = gK[tid + 512]; st[6] = gP[tid]; } while (0)
#define DN_ISSUE_U(it_) do { const size_t _it = (size_t)(it_); \
        _Pragma("unroll") for (int mt = 0; mt < 4; ++mt) unext[mt] = *(const f32x4*)(Ug + _it * 8192 + ((w * 4 + mt) * 64 + lane) * 4); } while (0)
    DN_ISSUE_ST(chain * 64);
    DN_ISSUE_U(chain * 64);
    float gln = GLg[chain * 64];
    DN_WRITE(0);
    DN_ISSUE_ST(chain * 64 + 1);
    __syncthreads();
    for (int n = 0; n < 64; ++n) {
        const int it = chain * 64 + n;
        f32x4 ucur[4];
#pragma unroll
        for (int mt = 0; mt < 4; ++mt) ucur[mt] = unext[mt];
        const float eg = __expf(gln);
        if (n == 22 || n == 42) {
            if (tid == 0) { unsigned* hc = half_cnt + (n == 22 ? 0 : 32); XB_SPIN(xb_ld(hc) < half_need, (unsigned*)(p.ws + OFF_BAR)); }
            __syncthreads();
            __builtin_amdgcn_fence(__ATOMIC_ACQUIRE, "agent"); asm volatile("s_waitcnt vmcnt(0)" ::: "memory");
        }
        const int itn = n < 63 ? it + 1 : it, itn2 = n < 62 ? it + 2 : it;
        DN_ISSUE_U(itn);
        gln = GLg[itn];
        const int rowb = b * SEQ + n * 64;
        if (n > 0) {
            LAS unsigned char* ob = lds + 124928 + ((n - 1) & 1) * 16384;
#pragma unroll
            for (int i = 0; i < 2; ++i) { const int q = tid + 512 * i, row = q >> 4, cc = q & 15;
                *(u32x4*)(ORAW + (size_t)(rowb - 64 + row) * 512 + h * 128 + cc * 8) = *(LAS u32x4*)(ob + row * 256 + cc * 16); }
        }
        LAS unsigned char* bb = lds + (n & 1) * 62464;
        bf16x8 Sb[4];
#pragma unroll
        for (int ks = 0; ks < 4; ++ks) Sb[ks] = pack8(S[2 * ks], S[2 * ks + 1]);
        f32x4 vn[4], oa[4];
#pragma unroll
        for (int mt = 0; mt < 4; ++mt) {
            bf16x8 Aw[4], Aq[4];
#pragma unroll
            for (int ks = 0; ks < 4; ++ks) { Aw[ks] = ldA_split(bb, 16 * mt + fr, 32 * ks + 4 * fq, 272); Aq[ks] = ldA_split(bb + 17408, 16 * mt + fr, 32 * ks + 4 * fq, 272); }
            __builtin_amdgcn_sched_barrier(0);
            f32x4 a1 = (f32x4){0.f, 0.f, 0.f, 0.f}, a2 = (f32x4){0.f, 0.f, 0.f, 0.f};
#pragma unroll
            for (int ks = 0; ks < 4; ++ks) { a1 = MFMA16(Aw[ks], Sb[ks], a1); a2 = MFMA16(Aq[ks], Sb[ks], a2); }
            vn[mt] = ucur[mt] - a1; oa[mt] = a2;
            __builtin_amdgcn_sched_barrier(0);
        }
        bf16x8 Vb[2];
        Vb[0] = pack8(vn[0], vn[1]); Vb[1] = pack8(vn[2], vn[3]);
#pragma unroll
        for (int hf = 0; hf < 2; ++hf) {
            bf16x8 Ak[4][2];
#pragma unroll
            for (int d = 0; d < 4; ++d)
#pragma unroll
                for (int k2 = 0; k2 < 2; ++k2) Ak[d][k2] = ldA_split(bb + 34816, 16 * (4 * hf + d) + fr, 32 * k2 + 4 * fq, 144);
            __builtin_amdgcn_sched_barrier(0);
#pragma unroll
            for (int d = 0; d < 4; ++d) { const int dt = 4 * hf + d; S[dt] = S[dt] * eg;
#pragma unroll
                for (int k2 = 0; k2 < 2; ++k2) S[dt] = MFMA16(Ak[d][k2], Vb[k2], S[dt]); }
            __builtin_amdgcn_sched_barrier(0);
        }
        {
            bf16x8 Ap[4][2];
#pragma unroll
            for (int mt = 0; mt < 4; ++mt)
#pragma unroll
                for (int k2 = 0; k2 < 2; ++k2) Ap[mt][k2] = ldA_split(bb + 53248, 16 * mt + fr, 32 * k2 + 4 * fq, 144);
            __builtin_amdgcn_sched_barrier(0);
#pragma unroll
            for (int mt = 0; mt < 4; ++mt)
#pragma unroll
                for (int k2 = 0; k2 < 2; ++k2) oa[mt] = MFMA16(Ap[mt][k2], Vb[k2], oa[mt]);
        }
        { LAS unsigned char* ob = lds + 124928 + (n & 1) * 16384 + (16 * w + fr) * 2;
#pragma unroll
          for (int mt = 0; mt < 4; ++mt)
#pragma unroll
              for (int e = 0; e < 4; ++e) *(LAS bf16_t*)(ob + (16 * mt + 4 * fq + e) * 256) = f2bf(oa[mt][e]); }
        DN_WRITE(((n + 1) & 1) * 62464);
        DN_ISSUE_ST(itn2);
        __syncthreads();
    }
    {
        const int rowl = b * SEQ + 63 * 64; LAS unsigned char* ob = lds + 124928 + 16384;
#pragma unroll
        for (int i = 0; i < 2; ++i) { const int q = tid + 512 * i, row = q >> 4, cc = q & 15;
            *(u32x4*)(ORAW + (size_t)(rowl + row) * 512 + h * 128 + cc * 8) = *(LAS u32x4*)(ob + row * 256 + cc * 16); }
    }
#undef DN_ISSUE_ST
#undef DN_ISSUE_U
#undef DN_WRITE
}

__device__ __forceinline__ void dn_gate_phase(int lj) {
    const Params p = load_params();
    const int tid = tid_fresh();
    bf16_t* proj = (bf16_t*)(p.ws + S_PROJ); const bf16_t* ORAW = (const bf16_t*)(p.out + (size_t)16 * 1024 * 1024);
    const int sub = tid & 15;
    const f32x4 nw0 = *(const f32x4*)(p.hyb_norm_w + lj * 128 + sub * 8), nw1 = *(const f32x4*)(p.hyb_norm_w + lj * 128 + sub * 8 + 4);
    const float nwv[8] = {nw0[0], nw0[1], nw0[2], nw0[3], nw1[0], nw1[1], nw1[2], nw1[3]};
    for (int pr = (blockIdx.x * 512 + tid) >> 4; pr < MTOK * 4; pr += (gridDim.x * 512) >> 4) {
        const int row = pr >> 2, hh = pr & 3;
        const u32x4 ov = *(const u32x4*)(ORAW + (size_t)row * 512 + hh * 128 + sub * 8);
        bf16_t* zp = proj + (size_t)row * HPP + 2304 + hh * 128 + sub * 8;
        const u32x4 zv = *(const u32x4*)zp;
        const float o[8] = {bflo(ov.x), bfhi(ov.x), bflo(ov.y), bfhi(ov.y), bflo(ov.z), bfhi(ov.z), bflo(ov.w), bfhi(ov.w)};
        const float z[8] = {bflo(zv.x), bfhi(zv.x), bflo(zv.y), bfhi(zv.y), bflo(zv.z), bfhi(zv.z), bflo(zv.w), bfhi(zv.w)};
        float ss = 0.f;
#pragma unroll
        for (int d = 0; d < 8; ++d) ss += o[d] * o[d];
        ss = row16_sum(ss);
        const float rstd = rsqrtf(ss * (1.0f / 128.0f) + 1e-6f);
        float r[8];
#pragma unroll
        for (int d = 0; d < 8; ++d) r[d] = o[d] * rstd * nwv[d] * (z[d] * sigmoidf_(z[d]));
        u32x4 w; w.x = cvt_pk_bf16(r[0], r[1]); w.y = cvt_pk_bf16(r[2], r[3]); w.z = cvt_pk_bf16(r[4], r[5]); w.w = cvt_pk_bf16(r[6], r[7]);
        *(u32x4*)zp = w;
    }
}

__device__ __forceinline__ void attn_items(LAS unsigned char* lds, int lj, int ab, int nab) {
    const Params p = load_params();
    const int tid = tid_fresh(), w = __builtin_amdgcn_readfirstlane(tid >> 6), lane = tid & 63, fr = lane & 15, fq = lane >> 4;
    bf16_t* proj = (bf16_t*)(p.ws + S_PROJ); const float* rope = (const float*)(p.ws + OFF_ROPE);
    LAS unsigned char* KS = lds; LAS unsigned char* VT = lds + 36864;
    for (int item = ab; item < 512; item += nab) {
        const int kvh = item & 1, nb = (item >> 1) & 31, b = item >> 6;
        {
            const int kb = tid >> 1, hf = tid & 1, pos = (nb - 1) * 128 + kb;
            u32x4 o1a = (u32x4){0u, 0u, 0u, 0u}, o1b = o1a, o2a = o1a, o2b = o1a;
            if (pos >= 0) {
                const bf16_t* kp = proj + (size_t)(b * SEQ + pos) * HPP + 512 + kvh * 64 + 16 * hf;
                const u32x4 x1a = *(const u32x4*)kp, x1b = *(const u32x4*)(kp + 8), x2a = *(const u32x4*)(kp + 32), x2b = *(const u32x4*)(kp + 40);
                const float x1[16] = {bflo(x1a.x), bfhi(x1a.x), bflo(x1a.y), bfhi(x1a.y), bflo(x1a.z), bfhi(x1a.z), bflo(x1a.w), bfhi(x1a.w), bflo(x1b.x), bfhi(x1b.x), bflo(x1b.y), bfhi(x1b.y), bflo(x1b.z), bfhi(x1b.z), bflo(x1b.w), bfhi(x1b.w)};
                const float x2[16] = {bflo(x2a.x), bfhi(x2a.x), bflo(x2a.y), bfhi(x2a.y), bflo(x2a.z), bfhi(x2a.z), bflo(x2a.w), bfhi(x2a.w), bflo(x2b.x), bfhi(x2b.x), bflo(x2b.y), bfhi(x2b.y), bflo(x2b.z), bfhi(x2b.z), bflo(x2b.w), bfhi(x2b.w)};
                const float* rp = rope + ((size_t)pos * 32 + 16 * hf) * 2;
                float r1[16], r2[16];
#pragma unroll
                for (int d2 = 0; d2 < 8; ++d2) { const f32x4 cs = *(const f32x4*)(rp + d2 * 4);
                    r1[2 * d2] = x1[2 * d2] * cs[0] - x2[2 * d2] * cs[1]; r2[2 * d2] = x2[2 * d2] * cs[0] + x1[2 * d2] * cs[1];
                    r1[2 * d2 + 1] = x1[2 * d2 + 1] * cs[2] - x2[2 * d2 + 1] * cs[3]; r2[2 * d2 + 1] = x2[2 * d2 + 1] * cs[2] + x1[2 * d2 + 1] * cs[3]; }
                o1a.x = cvt_pk_bf16(r1[0], r1[1]); o1a.y = cvt_pk_bf16(r1[2], r1[3]); o1a.z = cvt_pk_bf16(r1[4], r1[5]); o1a.w = cvt_pk_bf16(r1[6], r1[7]);
                o1b.x = cvt_pk_bf16(r1[8], r1[9]); o1b.y = cvt_pk_bf16(r1[10], r1[11]); o1b.z = cvt_pk_bf16(r1[12], r1[13]); o1b.w = cvt_pk_bf16(r1[14], r1[15]);
                o2a.x = cvt_pk_bf16(r2[0], r2[1]); o2a.y = cvt_pk_bf16(r2[2], r2[3]); o2a.z = cvt_pk_bf16(r2[4], r2[5]); o2a.w = cvt_pk_bf16(r2[6], r2[7]);
                o2b.x = cvt_pk_bf16(r2[8], r2[9]); o2b.y = cvt_pk_bf16(r2[10], r2[11]); o2b.z = cvt_pk_bf16(r2[12], r2[13]); o2b.w = cvt_pk_bf16(r2[14], r2[15]);
            }
            LAS unsigned char* kd = KS + kb * 144 + hf * 32;
            *(LAS u32x4*)kd = o1a; *(LAS u32x4*)(kd + 16) = o1b; *(LAS u32x4*)(kd + 64) = o2a; *(LAS u32x4*)(kd + 80) = o2b;
        }
        {
#pragma unroll
            for (int i = 0; i < 4; ++i) { const int q = tid + 512 * i, key = q >> 3, dc = q & 7, pos = (nb - 1) * 128 + key;
                u32x4 v = (u32x4){0u, 0u, 0u, 0u};
                if (pos >= 0) v = *(const u32x4*)(proj + (size_t)(b * SEQ + pos) * HPP + 640 + kvh * 64 + 8 * dc);
                LAS bf16_t* vd = (LAS bf16_t*)VT + (8 * dc) * 280 + key;
                vd[0] = (bf16_t)(v.x & 0xffffu); vd[280] = (bf16_t)(v.x >> 16); vd[2 * 280] = (bf16_t)(v.y & 0xffffu); vd[3 * 280] = (bf16_t)(v.y >> 16);
                vd[4 * 280] = (bf16_t)(v.z & 0xffffu); vd[5 * 280] = (bf16_t)(v.z >> 16); vd[6 * 280] = (bf16_t)(v.w & 0xffffu); vd[7 * 280] = (bf16_t)(v.w >> 16); }
            if (tid < 128) *(LAS u32x4*)(VT + (tid >> 1) * 560 + 512 + (tid & 1) * 16) = (u32x4){0u, 0u, 0u, 0u};
        }
        __syncthreads();
        const int qi = 16 * w + fr, pos_q = nb * 128 + qi, rowq = b * SEQ + pos_q;
        const int dl = fr - 4 * fq;
#pragma unroll 1
        for (int g = 0; g < 4; ++g) {
            const int head = kvh * 4 + g;
            bf16x8 Qf[2];
            { const bf16_t* qp = proj + (size_t)rowq * HPP + head * 64 + 8 * fq;
              const u32x4 xa = *(const u32x4*)qp, xb = *(const u32x4*)(qp + 32);
              const float x1[8] = {bflo(xa.x), bfhi(xa.x), bflo(xa.y), bfhi(xa.y), bflo(xa.z), bfhi(xa.z), bflo(xa.w), bfhi(xa.w)};
              const float x2[8] = {bflo(xb.x), bfhi(xb.x), bflo(xb.y), bfhi(xb.y), bflo(xb.z), bfhi(xb.z), bflo(xb.w), bfhi(xb.w)};
              const float* rp = rope + ((size_t)pos_q * 32 + 8 * fq) * 2;
              float r1[8], r2[8];
#pragma unroll
              for (int d2 = 0; d2 < 4; ++d2) { const f32x4 cs = *(const f32x4*)(rp + d2 * 4);
                  r1[2 * d2] = (x1[2 * d2] * cs[0] - x2[2 * d2] * cs[1]) * 0.125f; r2[2 * d2] = (x2[2 * d2] * cs[0] + x1[2 * d2] * cs[1]) * 0.125f;
                  r1[2 * d2 + 1] = (x1[2 * d2 + 1] * cs[2] - x2[2 * d2 + 1] * cs[3]) * 0.125f; r2[2 * d2 + 1] = (x2[2 * d2 + 1] * cs[2] + x1[2 * d2 + 1] * cs[3]) * 0.125f; }
              u32x4 a, c; a.x = cvt_pk_bf16(r1[0], r1[1]); a.y = cvt_pk_bf16(r1[2], r1[3]); a.z = cvt_pk_bf16(r1[4], r1[5]); a.w = cvt_pk_bf16(r1[6], r1[7]);
              c.x = cvt_pk_bf16(r2[0], r2[1]); c.y = cvt_pk_bf16(r2[2], r2[3]); c.z = cvt_pk_bf16(r2[4], r2[5]); c.w = cvt_pk_bf16(r2[6], r2[7]);
              Qf[0] = __builtin_bit_cast(bf16x8, a); Qf[1] = __builtin_bit_cast(bf16x8, c); }
            const float sink = p.hyb_sinks[lj * 8 + head];
            f32x4 sc[9];
            float mx = sink;
#pragma unroll
            for (int tt = 0; tt < 9; ++tt) {
                const int kt = w + tt;
                const bf16x8 k0 = *(LAS bf16x8*)(KS + (16 * kt + fr) * 144 + fq * 16), k1 = *(LAS bf16x8*)(KS + (16 * kt + fr) * 144 + 64 + fq * 16);
                f32x4 a = (f32x4){0.f, 0.f, 0.f, 0.f};
                a = MFMA16(k0, Qf[0], a); a = MFMA16(k1, Qf[1], a);
                const bool dead = (nb == 0) && (kt < 8);
#pragma unroll
                for (int e = 0; e < 4; ++e) { bool valid = !dead;
                    if (tt == 0) valid = valid && (e > dl);
                    if (tt == 8) valid = valid && (e <= dl);
                    a[e] = valid ? a[e] : -INFINITY; mx = fmaxf(mx, a[e]); }
                sc[tt] = a;
            }
            mx = fmaxf(mx, __shfl_xor(mx, 16)); mx = fmaxf(mx, __shfl_xor(mx, 32));
            float l = 0.f;
#pragma unroll
            for (int tt = 0; tt < 9; ++tt)
#pragma unroll
                for (int e = 0; e < 4; ++e) { const float pv = __expf(sc[tt][e] - mx); sc[tt][e] = pv; l += pv; }
            l += __shfl_xor(l, 16); l += __shfl_xor(l, 32);
            l += __expf(sink - mx);
            const float inv = 1.0f / l;
            f32x4 oacc[4];
#pragma unroll
            for (int mt = 0; mt < 4; ++mt) oacc[mt] = (f32x4){0.f, 0.f, 0.f, 0.f};
#pragma unroll
            for (int kk = 0; kk < 5; ++kk) {
                const bf16x8 Pb = pack8(sc[2 * kk], kk < 4 ? sc[2 * kk + 1] : (f32x4){0.f, 0.f, 0.f, 0.f});
                const int key0 = 16 * (w + 2 * kk) + 4 * fq;
#pragma unroll
                for (int mt = 0; mt < 4; ++mt) oacc[mt] = MFMA16(ldA_split(VT, 16 * mt + fr, key0, 560), Pb, oacc[mt]);
            }
            bf16_t* op = proj + (size_t)rowq * HPP + 1792 + head * 64 + 4 * fq;
#pragma unroll
            for (int mt = 0; mt < 4; ++mt) { u32x2 o; o.x = cvt_pk_bf16(oacc[mt][0] * inv, oacc[mt][1] * inv); o.y = cvt_pk_bf16(oacc[mt][2] * inv, oacc[mt][3] * inv); *(u32x2*)(op + 16 * mt) = o; }
        }
        __syncthreads();
    }
}

#define GSYNC() do { TSM(ph_cls); xcd_barrier((unsigned*)(load_params().ws + OFF_BAR), xb_x, (volatile LAS unsigned*)(lds + LDS_CTL + 128)); TSM(2); } while (0)
template <int layer>
__device__ __forceinline__ void layer_body(LAS unsigned char* lds, const unsigned xb_x, const int G, const int bid) {
    int ph_cls = 0; (void)ph_cls;
        const int lj = layer >> 1;
        if ((layer & 1) == 0) {
            {
                const Params p = load_params();
                pg8::Gemm g{(const bf16_t*)(p.ws + OFF_XB), (const bf16_t*)(p.ws + WB_HIN) + (size_t)lj * 3072 * 1024, MTOK, 3072, 1024, 1024};
                pg8::Order S; S.init(MTOK, 3072, G, bid, 0);
                pg8::EpiProjHyb E{(bf16_t*)(p.ws + S_PROJ), (float*)(p.ws + S_BL)};
                PHC(1); pg8::gemm_phase(lds, g, S, E);
            }
            GSYNC();
            PHC(3); dn_local_phase(lds, lj, 0, 24, bid, G);
            GSYNC();
            PHC(7);
            {
                unsigned* half_cnt = (unsigned*)(load_params().ws + OFF_BAR) + 4096 + 64 * lj;
                if (bid < 32) dn_scan_chain(lds, lj, bid, half_cnt, (unsigned)(G - 32));
                else {
                    dn_local_phase(lds, lj, 24, 20, bid - 32, G - 32);
                    asm volatile("s_waitcnt vmcnt(0)" ::: "memory"); __syncthreads();
                    if (threadIdx.x == 0) { __builtin_amdgcn_fence(__ATOMIC_RELEASE, "agent"); asm volatile("s_waitcnt vmcnt(0)" ::: "memory"); (void)xb_add(half_cnt, 1u); }
                    dn_local_phase(lds, lj, 44, 20, bid - 32, G - 32);
                    asm volatile("s_waitcnt vmcnt(0)" ::: "memory"); __syncthreads();
                    if (threadIdx.x == 0) { __builtin_amdgcn_fence(__ATOMIC_RELEASE, "agent"); asm volatile("s_waitcnt vmcnt(0)" ::: "memory"); (void)xb_add(half_cnt + 32, 1u); }
                    attn_items(lds, lj, bid - 32, G - 32);
                }
            }
            GSYNC();
            PHC(3); dn_gate_phase(lj);
            GSYNC();
            {
                const Params p = load_params();
                pg8::Gemm g{(const bf16_t*)(p.ws + S_PROJ) + 1792, (const bf16_t*)(p.ws + WB_HOUT) + (size_t)lj * 1024 * 1024, MTOK, 1024, 1024, HPP};
                pg8::Order S; S.init(MTOK, 1024, G, bid, 0);
                pg8::EpiResid E{(const bf16_t*)(p.ws + OFF_XB), (bf16_t*)(p.ws + OFF_Y)};
                PHC(1); pg8::gemm_phase(lds, g, S, E);
            }
        } else {
            {
                const Params p = load_params();
                pg8::Gemm g{(const bf16_t*)(p.ws + OFF_XB), (const bf16_t*)(p.ws + WB_RIN) + (size_t)lj * 2048 * 1024, MTOK, 2048, 1024, 1024};
                pg8::Order S; S.init(MTOK, 2048, G, bid, 0);
                pg8::EpiBf16<0> E{(bf16_t*)(p.ws + S_PROJ2), 2048};
                PHC(1); pg8::gemm_phase(lds, g, S, E);
            }
            GSYNC();
            { const Params p = load_params();
              PHC(4); rconv_phase((const bf16_t*)(p.ws + S_PROJ2), p.rec_conv_w + (size_t)lj * 4 * 1024, p.rec_conv_b + lj * 1024, (bf16_t*)(p.ws + S_XRC)); }
            GSYNC();
            {
                const Params p = load_params();
                pg8::Gemm g{(const bf16_t*)(p.ws + S_XRC), (const bf16_t*)(p.ws + WB_RG) + (size_t)lj * 2048 * 256, MTOK, 2048, 256, 1024};
                pg8::Order S; S.init(MTOK, 2048, G, bid, 1);
                pg8::EpiBf16<0> E{(bf16_t*)(p.ws + S_LA), 2048};
                PHC(1); pg8::gemm_phase(lds, g, S, E);
            }
            GSYNC();
            { const Params p = load_params(); PHC(4); rscan_phase<1>((const bf16_t*)(p.ws + S_LA), (const bf16_t*)(p.ws + S_XRC), p.rec_b_a + lj * 1024, p.rec_b_x + lj * 1024, p.rec_lambda + lj * 1024, (float*)(p.ws + S_CLA), (float*)(p.ws + S_CH), (bf16_t*)(p.ws + S_PROJ2), (unsigned*)p.out); }
            GSYNC();
            { const Params p = load_params(); PHC(4); rscan_phase<2>((const bf16_t*)(p.ws + S_LA), (const bf16_t*)(p.ws + S_XRC), p.rec_b_a + lj * 1024, p.rec_b_x + lj * 1024, p.rec_lambda + lj * 1024, (float*)(p.ws + S_CLA), (float*)(p.ws + S_CH), (bf16_t*)(p.ws + S_PROJ2), (unsigned*)p.out); }
            GSYNC();
            {
                const Params p = load_params();
                pg8::Gemm g{(const bf16_t*)(p.ws + S_PROJ2), (const bf16_t*)(p.ws + WB_ROUT) + (size_t)lj * 1024 * 1024, MTOK, 1024, 1024, 2048};
                pg8::Order S; S.init(MTOK, 1024, G, bid, 0);
                pg8::EpiResid E{(const bf16_t*)(p.ws + OFF_XB), (bf16_t*)(p.ws + OFF_Y)};
                PHC(1); pg8::gemm_phase(lds, g, S, E);
            }
        }
        GSYNC();
        { const Params p = load_params(); PHC(5); ln_phase((const bf16_t*)(p.ws + OFF_Y), p.ln1_g + layer * 1024, p.ln1_b + layer * 1024, (bf16_t*)(p.ws + OFF_XB), nullptr); }
        GSYNC();
        {
            const Params p = load_params();
            pg8::Gemm g{(const bf16_t*)(p.ws + OFF_XB), (const bf16_t*)(p.ws + WB_W1) + (size_t)layer * 4096 * 1024, MTOK, 4096, 1024, 1024};
            pg8::Order S; S.init(MTOK, 4096, G, bid, 0);
            pg8::EpiBf16<1> E{(bf16_t*)(p.ws + S_H), 4096};
            PHC(1); pg8::gemm_phase(lds, g, S, E);
        }
        GSYNC();
        {
            const Params p = load_params();
            pg8::Gemm g{(const bf16_t*)(p.ws + S_H), (const bf16_t*)(p.ws + WB_W2) + (size_t)layer * 1024 * 4096, MTOK, 1024, 4096, 4096};
            pg8::Order S; S.init(MTOK, 1024, G, bid, 0);
            pg8::EpiResid E{(const bf16_t*)(p.ws + OFF_XB), (bf16_t*)(p.ws + OFF_Y)};
            PHC(1); pg8::gemm_phase(lds, g, S, E);
        }
        GSYNC();
        { const Params p = load_params(); PHC(5); ln_phase((const bf16_t*)(p.ws + OFF_Y), p.ln2_g + layer * 1024, p.ln2_b + layer * 1024, (bf16_t*)(p.ws + OFF_XB), layer == 3 ? p.out : nullptr); }
        if (layer < 3) GSYNC();
#ifdef TS_SELECT
        else GSYNC();
#endif
}

__global__ void __launch_bounds__(512) mega_fwd(Params p_unused) {
    extern __shared__ __attribute__((aligned(16))) unsigned char smem_raw[];
    LAS unsigned char* lds = (LAS unsigned char*)smem_raw;
    cg::grid_group grid = cg::this_grid();
    grid.sync();
    const int G = gridDim.x, bid = blockIdx.x;
    if (threadIdx.x < 2) ((LAS unsigned*)(lds + LDS_CTL + 128))[threadIdx.x] = 0u;
    __syncthreads();
    const unsigned xb_x = xb_xcc_id();
    if (threadIdx.x == 0) (void)xb_add(&((unsigned*)(load_params().ws + OFF_BAR))[XB_XCNT(xb_x)], 1u);
#ifdef TS_SELECT
    int ph_cls = 0;
    if (threadIdx.x < 64) ((LAS unsigned*)(lds + LDS_CTL))[threadIdx.x] = 0u;
    __syncthreads();
    if (blockIdx.x == TS_BLOCK && threadIdx.x == 0) { ((LAS unsigned*)(lds + LDS_CTL))[0] = (unsigned)__builtin_amdgcn_s_memrealtime(); ((LAS unsigned*)(lds + LDS_CTL))[1] = ((LAS unsigned*)(lds + LDS_CTL))[0]; }
#endif

    prep_phase(lds);
    GSYNC();

    layer_body<0>(lds, xb_x, G, bid);
    layer_body<1>(lds, xb_x, G, bid);
    layer_body<2>(lds, xb_x, G, bid);
    layer_body<3>(lds, xb_x, G, bid);
#ifdef TS_SELECT
    if (blockIdx.x == TS_BLOCK) {
        LAS unsigned* tw = (LAS unsigned*)(lds + LDS_CTL);
        unsigned ticks = (TS_SELECT == 6) ? (tw[0] - tw[1]) : tw[2 + TS_SELECT];
        const unsigned K = ticks / 50u; float* o = load_params().out;
        for (unsigned i = threadIdx.x; i < K; i += 512) o[i] += 0.09f;
    }
#endif
}

extern "C" void kernel_launch(void* const* d_in, const int* in_sizes, int n_in, void* d_out, int out_size, void* d_ws, size_t ws_size, hipStream_t stream) {
    static int grid = 0;
    if (grid == 0) {
        if (n_in != 23 || out_size != MTOK * DM || ws_size < WS_NEED) { fprintf(stderr, "kernel_launch: unexpected shapes (n_in %d, out %d, ws %zu)\n", n_in, out_size, ws_size); grid = -1; return; }
        int dev = 0, cus = 0, per_cu = 0;
        (void)hipGetDevice(&dev); (void)hipDeviceGetAttribute(&cus, hipDeviceAttributeMultiprocessorCount, dev);
        if (hipFuncSetAttribute((const void*)mega_fwd, hipFuncAttributeMaxDynamicSharedMemorySize, LDS_BYTES) != hipSuccess) { fprintf(stderr, "kernel_launch: hipFuncSetAttribute failed\n"); grid = -1; return; }
        (void)hipOccupancyMaxActiveBlocksPerMultiprocessor(&per_cu, (const void*)mega_fwd, 512, LDS_BYTES);
        if (per_cu < 1) { fprintf(stderr, "kernel_launch: occupancy query says 0\n"); per_cu = 1; }
        (void)hipGetLastError();
        grid = cus;
    }
    if (grid < 0) return;
    (void)hipMemsetAsync((char*)d_ws + OFF_BAR, 0, 32768, stream);
    Params p{};
    const float** pp = (const float**)&p;
    for (int i = 0; i < 23; ++i) pp[i] = (const float*)d_in[i];
    p.out = (float*)d_out; p.ws = (unsigned char*)d_ws;
    void* args[] = {&p};
    hipError_t e = hipLaunchCooperativeKernel((const void*)mega_fwd, dim3(grid), dim3(512), args, LDS_BYTES, stream);
    if (e != hipSuccess) fprintf(stderr, "cooperative launch failed: %s (grid %d)\n", hipGetErrorString(e), grid);
}
```

```cpp
#include <hip/hip_runtime.h>
#include <hip/hip_cooperative_groups.h>
#include <cstdio>
#include <cstdint>
namespace cg = cooperative_groups;

#define LAS __attribute__((address_space(3)))
typedef unsigned short bf16_t;
typedef short bf16x8 __attribute__((ext_vector_type(8)));
typedef short bf16x4 __attribute__((ext_vector_type(4)));
typedef float f32x4 __attribute__((ext_vector_type(4)));
typedef float f32x2 __attribute__((ext_vector_type(2)));
typedef unsigned u32x4 __attribute__((ext_vector_type(4)));
typedef unsigned u32x2 __attribute__((ext_vector_type(2)));

constexpr int MTOK = 32768, DM = 1024, SEQ = 4096;
constexpr int HPP = 3072;
constexpr float DN_ALPHA = 1.6817928305074290f;
constexpr size_t MiB = 1024ull * 1024ull;
constexpr size_t WB_HIN = 0;
constexpr size_t WB_HOUT = WB_HIN + 2ull * 3072 * 1024 * 2;
constexpr size_t WB_RIN = WB_HOUT + 2ull * 1024 * 1024 * 2;
constexpr size_t WB_RG = WB_RIN + 2ull * 2048 * 1024 * 2;
constexpr size_t WB_ROUT = WB_RG + 2ull * 2048 * 256 * 2;
constexpr size_t WB_W1 = WB_ROUT + 2ull * 1024 * 1024 * 2;
constexpr size_t WB_W2 = WB_W1 + 4ull * 4096 * 1024 * 2;
constexpr size_t WB_END = WB_W2 + 4ull * 4096 * 1024 * 2;
static_assert(WB_END <= 96 * MiB, "weights");
constexpr size_t OFF_XB = 96 * MiB;
constexpr size_t OFF_ROPE = 160 * MiB;
constexpr size_t OFF_BAR = 161 * MiB;
constexpr size_t OFF_SCR = 162 * MiB;
constexpr size_t S_PROJ = OFF_SCR;
constexpr size_t S_BL = S_PROJ + 192 * MiB;
constexpr size_t S_QG = S_BL + 1 * MiB;
constexpr size_t S_KT = S_QG + 32 * MiB;
constexpr size_t S_W = S_KT + 32 * MiB;
constexpr size_t S_QK = S_W + 32 * MiB;
constexpr size_t S_GL = S_QK + 16 * MiB;
constexpr size_t S_PROJ2 = OFF_SCR;
constexpr size_t S_XRC = S_PROJ2 + 128 * MiB;
constexpr size_t S_LA = S_XRC + 64 * MiB;
constexpr size_t S_CLA = S_LA + 128 * MiB;
constexpr size_t S_CH = S_CLA + 2 * MiB;
constexpr size_t S_H = OFF_SCR;
constexpr size_t OFF_Y = 420 * MiB;
constexpr size_t WS_NEED = OFF_SCR + 326 * MiB;
constexpr int LDS_CTL = 157696;
constexpr int LDS_BYTES = LDS_CTL + 256;

struct Params {
    const float* x; const float* hyb_w_in; const float* hyb_sinks; const float* hyb_conv_w; const float* hyb_a_log; const float* hyb_dt_bias; const float* hyb_norm_w; const float* hyb_w_out;
    const float* rec_w_in; const float* rec_conv_w; const float* rec_conv_b; const float* rec_w_a; const float* rec_b_a; const float* rec_w_x; const float* rec_b_x; const float* rec_lambda; const float* rec_w_out;
    const float* ln1_g; const float* ln1_b; const float* mlp_w1; const float* mlp_w2; const float* ln2_g; const float* ln2_b;
    float* out; unsigned char* ws;
};

typedef const __attribute__((address_space(4))) Params* KParamsPtr;
__device__ __forceinline__ Params load_params() {
#if defined(__HIP_DEVICE_COMPILE__)
    KParamsPtr k = (KParamsPtr)__builtin_amdgcn_kernarg_segment_ptr(); asm volatile("" : "+s"(k));
    Params r; const __attribute__((address_space(4))) unsigned long long* q = (const __attribute__((address_space(4))) unsigned long long*)k; const char** d = (const char**)&r;
#pragma unroll
    for (int i = 0; i < (int)(sizeof(Params) / 8); ++i) { const __attribute__((address_space(1))) char* gp = (const __attribute__((address_space(1))) char*)q[i]; d[i] = (const char*)gp; }
    return r;
#else
    return Params{};
#endif
}
__device__ __forceinline__ int tid_fresh() { int t = threadIdx.x; asm volatile("" : "+v"(t)); return t; }
typedef __bf16 bf16x2_t __attribute__((ext_vector_type(2)));
__device__ __forceinline__ unsigned cvt_pk_bf16(float lo, float hi) { const f32x2 v = {lo, hi}; const bf16x2_t b = __builtin_convertvector(v, bf16x2_t); return __builtin_bit_cast(unsigned, b); }
__device__ __forceinline__ bf16_t f2bf(float f) { return (bf16_t)(cvt_pk_bf16(f, 0.f) & 0xffffu); }
__device__ __forceinline__ float bf2f(bf16_t b) { return __uint_as_float(((unsigned)b) << 16); }
__device__ __forceinline__ float bflo(unsigned u) { return __uint_as_float(u << 16); }
__device__ __forceinline__ float bfhi(unsigned u) { return __uint_as_float(u & 0xffff0000u); }
__device__ __forceinline__ float sigmoidf_(float x) { return 1.0f / (1.0f + __expf(-x)); }
__device__ __forceinline__ bf16x8 pack8(const f32x4 a, const f32x4 b) {
    u32x4 w; w.x = cvt_pk_bf16(a[0], a[1]); w.y = cvt_pk_bf16(a[2], a[3]); w.z = cvt_pk_bf16(b[0], b[1]); w.w = cvt_pk_bf16(b[2], b[3]);
    return __builtin_bit_cast(bf16x8, w);
}
__device__ __forceinline__ bf16x8 ldA_split(LAS unsigned char* base, int row, int col, int strideB) {
    const u32x2 lo = *(LAS u32x2*)(base + row * strideB + col * 2);
    const u32x2 hi = *(LAS u32x2*)(base + row * strideB + (col + 16) * 2);
    u32x4 w; w.x = lo.x; w.y = lo.y; w.z = hi.x; w.w = hi.y;
    return __builtin_bit_cast(bf16x8, w);
}
#define DPP_ADD(s, ctrl) ((s) + __builtin_bit_cast(float, __builtin_amdgcn_update_dpp(0, __builtin_bit_cast(int, (s)), (ctrl), 0xF, 0xF, true)))
__device__ __forceinline__ float row8_sum(float s) { s = DPP_ADD(s, 0xB1); s = DPP_ADD(s, 0x4E); s = DPP_ADD(s, 0x141); return s; }
__device__ __forceinline__ float row16_sum(float s) { s = row8_sum(s); s = DPP_ADD(s, 0x140); return s; }
__device__ __forceinline__ float wave64_sum(float s) { s = row16_sum(s);
    return (__builtin_bit_cast(float, __builtin_amdgcn_readlane(__builtin_bit_cast(int, s), 0)) + __builtin_bit_cast(float, __builtin_amdgcn_readlane(__builtin_bit_cast(int, s), 16)))
         + (__builtin_bit_cast(float, __builtin_amdgcn_readlane(__builtin_bit_cast(int, s), 32)) + __builtin_bit_cast(float, __builtin_amdgcn_readlane(__builtin_bit_cast(int, s), 48))); }
#define XB_TMO      128
#define XB_XCNT(j)  (256  + 64 * (j))
#define XB_XSUB(j)  (1280 + 64 * (j))
#define XB_XGEN(j)  (2304 + 64 * (j))
#define XB_TOP      3328
#define XB_TOPGEN   3392
#define XCD_BAR_WORDS 3456
#define XB_SPIN_CAP (1u << 22)
__device__ __forceinline__ unsigned xb_ld(unsigned* p)              { return __hip_atomic_load(p, __ATOMIC_RELAXED, __HIP_MEMORY_SCOPE_AGENT); }
__device__ __forceinline__ unsigned xb_add(unsigned* p, unsigned v) { return __hip_atomic_fetch_add(p, v, __ATOMIC_RELAXED, __HIP_MEMORY_SCOPE_AGENT); }
__device__ __forceinline__ unsigned xb_xcc_id() { return (unsigned)__builtin_amdgcn_s_getreg((3 << 11) | 20) & 0xFu; }
#define XB_SPIN(cond, bar) do { unsigned _sp = 0; while (cond) { __builtin_amdgcn_s_sleep(1); \
    if ((++_sp & 255u) == 0u) { if (xb_ld(&(bar)[XB_TMO])) break; if (_sp > XB_SPIN_CAP) { atomicAdd(&(bar)[XB_TMO], 1u); break; } } } } while (0)
__device__ __forceinline__ void xcd_barrier_complete(unsigned* bar, unsigned x, unsigned& nloc, unsigned& nx) {
    const unsigned G = gridDim.x;
    unsigned sum, cnt, mine, sp = 0u;
    for (;;) {
        sum = 0u; cnt = 0u; mine = 0u;
#pragma unroll
        for (unsigned j = 0; j < 16; ++j) { const unsigned c = xb_ld(&bar[XB_XCNT(j)]); sum += c; cnt += (c > 0u) ? 1u : 0u; mine = (j == x) ? c : mine; }
        if (sum == G) break;
        __builtin_amdgcn_s_sleep(1);
        if ((++sp & 255u) == 0u) { if (xb_ld(&bar[XB_TMO])) break; if (sp > XB_SPIN_CAP) { atomicAdd(&bar[XB_TMO], 1u); break; } }
    }
    nloc = mine > 0u ? mine : 1u; nx = cnt > 0u ? cnt : 1u;
}
__device__ __forceinline__ void xcd_barrier(unsigned* bar, const unsigned x, volatile LAS unsigned* st) {
    asm volatile("s_waitcnt vmcnt(0)" ::: "memory");
    __syncthreads();
    if (threadIdx.x == 0) {
        __builtin_amdgcn_s_waitcnt(0);
        unsigned nloc = st[0], nx = st[1];
        if (nloc == 0u) { xcd_barrier_complete(bar, x, nloc, nx); st[0] = nloc; st[1] = nx; }
        const unsigned old = xb_add(&bar[XB_XSUB(x)], 1u);
        const unsigned gen = old / nloc;
        if (old + 1u == (gen + 1u) * nloc) {
            __builtin_amdgcn_fence(__ATOMIC_RELEASE, "agent");
            asm volatile("s_waitcnt vmcnt(0)" ::: "memory");
            const unsigned og = xb_add(&bar[XB_TOP], 1u);
            const unsigned tg = og / nx;
            if (og + 1u == (tg + 1u) * nx) xb_add(&bar[XB_TOPGEN], 1u);
            else XB_SPIN(xb_ld(&bar[XB_TOPGEN]) == tg, bar);
            __builtin_amdgcn_fence(__ATOMIC_ACQUIRE, "agent");
            xb_add(&bar[XB_XGEN(x)], 1u);
            asm volatile("s_waitcnt vmcnt(0)" ::: "memory");
        } else {
            XB_SPIN(xb_ld(&bar[XB_XGEN(x)]) == gen, bar);
            __builtin_amdgcn_fence(__ATOMIC_ACQUIRE, "agent");
            asm volatile("s_waitcnt vmcnt(0)" ::: "memory");
        }
    }
    __syncthreads();
}
#ifdef TS_SELECT
__device__ __forceinline__ void ts_mark(LAS unsigned char* lds, int cls) {
    if (blockIdx.x == TS_BLOCK && threadIdx.x == 0) { LAS unsigned* tw = (LAS unsigned*)(lds + LDS_CTL); const unsigned now = (unsigned)__builtin_amdgcn_s_memrealtime();
        tw[2 + cls] += now - tw[0]; tw[0] = now; }
}
#define PHC(c) ph_cls = (c)
#define TSM(c) ts_mark(lds, (c) >= 8 ? 7 : (c))
#else
#define PHC(c)
#define TSM(c)
#endif
#define MFMA16(a, b, c) __builtin_amdgcn_mfma_f32_16x16x32_bf16((a), (b), (c), 0, 0, 0)

namespace pg8 {
constexpr int BM = 256, BK = 64, HALF = 128, HTB = HALF * BK * 2, STAGE_BYTES = 8 * HTB, NXCD = 8, WGM = 4;
__host__ __device__ __forceinline__ int lds_byte(int r, int c) { const int st = (r >> 4) * 2 + (c >> 5), rr = r & 15, cc = c & 31, ob = rr * 64 + cc * 2; return st * 1024 + (ob ^ (((ob >> 9) & 1) << 5)); }
__host__ __device__ __forceinline__ void stage_rc(int b, int& R, int& C) { const int st = b / 1024, sb = b % 1024, swz = sb ^ (((sb >> 9) & 1) << 5); R = (st >> 1) * 16 + swz / 64; C = (st & 1) * 32 + (swz % 64) / 2; }
__host__ __device__ __forceinline__ int perm32(int rho) { const int n = rho >> 4, i = rho & 15; return 8 * (i >> 2) + 4 * n + (i & 3); }

struct Unit { int pm, pn, ka; };
struct Gemm { const bf16_t* A; const bf16_t* Bt; int M, N, K, lda; };

struct Order {
    int nM, nN, nwg, G, c, gates;
    __device__ void init(int M, int N, int G_, int c_, int gates_) { nM = M / BM; nN = N / BM; nwg = nM * nN; G = G_; c = c_; gates = gates_; }
    __device__ bool next(int i, Unit& u) const {
        const long L = (long)i * G + c; if (L >= nwg) return false;
        int wgid = (int)L; { const int q = nwg / NXCD, r = nwg % NXCD, xcd = wgid % NXCD, off = wgid / NXCD; wgid = (xcd < r ? xcd * (q + 1) : r * (q + 1) + (xcd - r) * q) + off; }
        const int nig = WGM * nN, gid = wgid / nig, fm = gid * WGM, gsz = (nM - fm) < WGM ? (nM - fm) : WGM;
        u.pm = fm + ((wgid % nig) % gsz); u.pn = (wgid % nig) / gsz; u.ka = gates ? (u.pn >> 1) * 256 : 0; return true;
    }
};

template <class Epi>
__device__ __forceinline__ void gemm_phase(LAS unsigned char* lds, const Gemm g, const Order& S, const Epi& E) {
    const int tid = tid_fresh(), wid = __builtin_amdgcn_readfirstlane(tid >> 6), lane = tid & 63, wr = wid >> 2, wc = wid & 3, fr = lane & 15, fq = lane >> 4;
    const int K = g.K, nt = K / BK;
    unsigned voffA[2], voffB[2];
#pragma unroll
    for (int i = 0; i < 2; ++i) { int R, C; stage_rc(tid * 16 + i * 8192, R, C); const int Rb = Epi::PERM ? ((R & ~31) + perm32(R & 31)) : R;
        voffA[i] = (unsigned)(R * g.lda + C) * 2u; voffB[i] = (unsigned)(Rb * K + C) * 2u; }
    const size_t kstep = (size_t)(BK * 2);
    const size_t hstepA = (size_t)HALF * g.lda * 2, hstepB = (size_t)HALF * K * 2;
    const size_t tstepA = 2 * hstepA, tstepB = 2 * hstepB;
    const unsigned ldsw = (unsigned)wid * 1024u;
    const int aoff = lds_byte(wr * 64 + fr, fq * 8), boff = lds_byte(wc * 32 + fr, fq * 8);
#define PG8_SA(b, h) (((b) * 2 + (h)) * HTB)
#define PG8_SB(b, h) ((4 + (b) * 2 + (h)) * HTB)
#define PG8_STAGE(bufoff, gbase, voff) do { _Pragma("unroll") for (int _i = 0; _i < 2; ++_i) \
        __builtin_amdgcn_global_load_lds((const unsigned*)((const char*)(gbase) + (voff)[_i]), (LAS unsigned*)(lds + (bufoff) + ldsw + _i * 8192), 16, 0, 0); } while (0)
#define PG8_LDA(dst, b, h) do { _Pragma("unroll") for (int m = 0; m < 4; ++m) _Pragma("unroll") for (int k = 0; k < 2; ++k) dst[m][k] = *(const LAS bf16x8*)(lds + PG8_SA(b, h) + aoff + m * 2048 + k * 1024); } while (0)
#define PG8_LDB(dst, b, h) do { _Pragma("unroll") for (int n = 0; n < 2; ++n) _Pragma("unroll") for (int k = 0; k < 2; ++k) dst[n][k] = *(const LAS bf16x8*)(lds + PG8_SB(b, h) + boff + n * 2048 + k * 1024); } while (0)
#define PG8_MMA(ai, bj, At, Bt) do { __builtin_amdgcn_s_setprio(1); _Pragma("unroll") for (int m = 0; m < 4; ++m) _Pragma("unroll") for (int n = 0; n < 2; ++n) _Pragma("unroll") for (int k = 0; k < 2; ++k) \
        acc[ai][bj][m][n] = __builtin_amdgcn_mfma_f32_16x16x32_bf16(Bt[n][k], At[m][k], acc[ai][bj][m][n], 0, 0, 0); __builtin_amdgcn_s_setprio(0); } while (0)
#define PG8_WAIT_V(n) asm volatile("s_waitcnt vmcnt(" #n ")" ::: "memory")
#define PG8_WAIT_L(n) asm volatile("s_waitcnt lgkmcnt(" #n ")" ::: "memory")
#define PG8_BAR __builtin_amdgcn_s_barrier()
#define PG8_SCHED __builtin_amdgcn_sched_barrier(0)
    Unit cur, nxt; int ui = 0;
    if (!S.next(0, cur)) return;
    f32x4 acc[2][2][4][2];
#pragma unroll
    for (int a = 0; a < 2; ++a)
#pragma unroll
        for (int b = 0; b < 2; ++b)
#pragma unroll
            for (int m = 0; m < 4; ++m)
#pragma unroll
                for (int n = 0; n < 2; ++n) acc[a][b][m][n] = (f32x4){0.f, 0.f, 0.f, 0.f};
    bf16x8 At[4][2], B0[2][2], B1[2][2];
    const char* cA = (const char*)g.A + (size_t)cur.pm * tstepA + (size_t)cur.ka * 2; const char* cB = (const char*)g.Bt + (size_t)cur.pn * tstepB;
    PG8_STAGE(PG8_SB(0, 0), cB, voffB); PG8_STAGE(PG8_SB(0, 1), cB + hstepB, voffB); PG8_STAGE(PG8_SA(0, 0), cA, voffA); PG8_STAGE(PG8_SA(0, 1), cA + hstepA, voffA);
    if (wr == 1) PG8_BAR;
    PG8_WAIT_V(2); PG8_BAR;
    PG8_STAGE(PG8_SB(1, 0), cB + kstep, voffB); PG8_STAGE(PG8_SA(1, 0), cA + kstep, voffA); PG8_STAGE(PG8_SB(1, 1), cB + hstepB + kstep, voffB);
    PG8_WAIT_V(6); PG8_BAR;
    for (;;) {
        const bool has_next = S.next(ui + 1, nxt);
        const char* nA = has_next ? (const char*)g.A + (size_t)nxt.pm * tstepA + (size_t)nxt.ka * 2 : cA; const char* nB = has_next ? (const char*)g.Bt + (size_t)nxt.pn * tstepB : cB;
        for (int t = 0; t < nt; t += 2) {
            const bool last = (t == nt - 2);
            const char* a1 = cA + (size_t)(t + 1) * kstep;
            const char* a2 = last ? nA : cA + (size_t)(t + 2) * kstep; const char* b2 = last ? nB : cB + (size_t)(t + 2) * kstep;
            const char* a3 = a2 + kstep; const char* b3 = b2 + kstep;
            PG8_LDB(B0, 0, 0); PG8_LDB(B1, 0, 1); PG8_SCHED; PG8_LDA(At, 0, 0); PG8_STAGE(PG8_SA(1, 1), a1 + hstepA, voffA);
            PG8_WAIT_V(8); PG8_WAIT_L(0); PG8_BAR; PG8_MMA(0, 0, At, B0); PG8_MMA(0, 1, At, B1); PG8_BAR; PG8_SCHED;
            PG8_LDA(At, 0, 1); PG8_STAGE(PG8_SB(0, 0), b2, voffB); PG8_STAGE(PG8_SB(0, 1), b2 + hstepB, voffB); PG8_STAGE(PG8_SA(0, 0), a2, voffA);
            PG8_WAIT_V(8); PG8_WAIT_L(0); PG8_BAR; PG8_MMA(1, 0, At, B0); PG8_MMA(1, 1, At, B1); PG8_BAR; PG8_SCHED;
            PG8_LDB(B0, 1, 0); PG8_LDB(B1, 1, 1); PG8_SCHED; PG8_LDA(At, 1, 0); PG8_STAGE(PG8_SA(0, 1), a2 + hstepA, voffA);
            PG8_WAIT_V(8); PG8_WAIT_L(0); PG8_BAR; PG8_MMA(0, 0, At, B0); PG8_MMA(0, 1, At, B1); PG8_BAR; PG8_SCHED;
            PG8_LDA(At, 1, 1); PG8_STAGE(PG8_SB(1, 0), b3, voffB); PG8_STAGE(PG8_SB(1, 1), b3 + hstepB, voffB); PG8_STAGE(PG8_SA(1, 0), a3, voffA);
            PG8_WAIT_V(8); PG8_WAIT_L(0); PG8_BAR; PG8_MMA(1, 0, At, B0); PG8_MMA(1, 1, At, B1); PG8_BAR; PG8_SCHED;
        }
        if (wr == 0) PG8_BAR;
        E(acc, cur, wr, wc, fr, fq);
        if (!has_next) break;
#pragma unroll
        for (int a = 0; a < 2; ++a)
#pragma unroll
            for (int b = 0; b < 2; ++b)
#pragma unroll
                for (int m = 0; m < 4; ++m)
#pragma unroll
                    for (int n = 0; n < 2; ++n) acc[a][b][m][n] = (f32x4){0.f, 0.f, 0.f, 0.f};
        cur = nxt; cA = nA; cB = nB; ++ui;
        if (wr == 1) PG8_BAR;
    }
    PG8_WAIT_V(0);
    PG8_BAR;
#undef PG8_SA
#undef PG8_SB
#undef PG8_STAGE
#undef PG8_LDA
#undef PG8_LDB
#undef PG8_MMA
#undef PG8_WAIT_V
#undef PG8_WAIT_L
#undef PG8_BAR
#undef PG8_SCHED
}

typedef const f32x4 (&AccRef)[2][2][4][2];
template <int ACT> struct EpiBf16 {
    static constexpr bool PERM = true;
    bf16_t* O; int ldc;
    __device__ __forceinline__ void operator()(AccRef acc, const Unit& u, int wr, int wc, int fr, int fq) const {
        const int row0 = u.pm * BM + wr * 64 + fr, col0 = u.pn * BM + wc * 32 + 8 * fq;
#pragma unroll
        for (int ai = 0; ai < 2; ++ai)
#pragma unroll
            for (int m = 0; m < 4; ++m) { bf16_t* rowp = O + (size_t)(row0 + ai * HALF + m * 16) * ldc + col0;
#pragma unroll
                for (int bj = 0; bj < 2; ++bj) { f32x4 v0 = acc[ai][bj][m][0], v1 = acc[ai][bj][m][1];
                    if (ACT == 1) {
#pragma unroll
                        for (int j = 0; j < 4; ++j) { const float a = fmaxf(v0[j], 0.f), b = fmaxf(v1[j], 0.f); v0[j] = a * a; v1[j] = b * b; } }
                    u32x4 w; w.x = cvt_pk_bf16(v0[0], v0[1]); w.y = cvt_pk_bf16(v0[2], v0[3]); w.z = cvt_pk_bf16(v1[0], v1[1]); w.w = cvt_pk_bf16(v1[2], v1[3]);
                    *(u32x4*)(rowp + bj * HALF) = w; } }
    }
};
struct EpiProjHyb {
    static constexpr bool PERM = true;
    bf16_t* O; float* BL;
    __device__ __forceinline__ void operator()(AccRef acc, const Unit& u, int wr, int wc, int fr, int fq) const {
        const int row0 = u.pm * BM + wr * 64 + fr;
        if (u.pn == 11) {
            if (wc == 0 && fq == 0) {
#pragma unroll
                for (int ai = 0; ai < 2; ++ai)
#pragma unroll
                    for (int m = 0; m < 4; ++m) { float* bp = BL + (size_t)(row0 + ai * HALF + m * 16) * 8; *(f32x4*)bp = acc[ai][0][m][0]; *(f32x4*)(bp + 4) = acc[ai][0][m][1]; }
            }
            return;
        }
        const int col0 = u.pn * BM + wc * 32 + 8 * fq;
#pragma unroll
        for (int ai = 0; ai < 2; ++ai)
#pragma unroll
            for (int m = 0; m < 4; ++m) { bf16_t* rowp = O + (size_t)(row0 + ai * HALF + m * 16) * HPP + col0;
#pragma unroll
                for (int bj = 0; bj < 2; ++bj) { const f32x4 v0 = acc[ai][bj][m][0], v1 = acc[ai][bj][m][1];
                    u32x4 w; w.x = cvt_pk_bf16(v0[0], v0[1]); w.y = cvt_pk_bf16(v0[2], v0[3]); w.z = cvt_pk_bf16(v1[0], v1[1]); w.w = cvt_pk_bf16(v1[2], v1[3]);
                    *(u32x4*)(rowp + bj * HALF) = w; } }
    }
};
struct EpiResid {
    static constexpr bool PERM = true;
    const bf16_t* XB; bf16_t* Y;
    __device__ __forceinline__ void operator()(AccRef acc, const Unit& u, int wr, int wc, int fr, int fq) const {
        const int row0 = u.pm * BM + wr * 64 + fr, col0 = u.pn * BM + wc * 32 + 8 * fq;
#pragma unroll
        for (int ai = 0; ai < 2; ++ai)
#pragma unroll
            for (int m = 0; m < 4; ++m) { const size_t off = (size_t)(row0 + ai * HALF + m * 16) * DM + col0;
#pragma unroll
                for (int bj = 0; bj < 2; ++bj) { const size_t o = off + bj * HALF; const u32x4 xv = *(const u32x4*)(XB + o);
                    const f32x4 a0 = acc[ai][bj][m][0], a1 = acc[ai][bj][m][1];
                    u32x4 w;
                    w.x = cvt_pk_bf16(DN_ALPHA * bflo(xv.x) + a0[0], DN_ALPHA * bfhi(xv.x) + a0[1]); w.y = cvt_pk_bf16(DN_ALPHA * bflo(xv.y) + a0[2], DN_ALPHA * bfhi(xv.y) + a0[3]);
                    w.z = cvt_pk_bf16(DN_ALPHA * bflo(xv.z) + a1[0], DN_ALPHA * bfhi(xv.z) + a1[1]); w.w = cvt_pk_bf16(DN_ALPHA * bflo(xv.w) + a1[2], DN_ALPHA * bfhi(xv.w) + a1[3]);
                    *(u32x4*)(Y + o) = w; } }
    }
};
}

__device__ __forceinline__ void transpose_tile(const float* __restrict__ src, int ld, int K, int Nvalid, bf16_t* __restrict__ dst, int k0, int n0, LAS float* tile, const int tid) {
    { const int n = tid & 63, kk = tid >> 6;
#pragma unroll
      for (int i = 0; i < 8; ++i) { const int k = kk + 8 * i; tile[k * 65 + n] = (n0 + n < Nvalid) ? src[(size_t)(k0 + k) * ld + n0 + n] : 0.f; } }
    __syncthreads();
    { const int k2 = (tid & 31) * 2, nn = tid >> 5;
#pragma unroll
      for (int i = 0; i < 4; ++i) { const int n = nn + 16 * i; *(unsigned*)(dst + (size_t)(n0 + n) * K + k0 + k2) = cvt_pk_bf16(tile[k2 * 65 + n], tile[(k2 + 1) * 65 + n]); } }
    __syncthreads();
}

__device__ __forceinline__ void prep_phase(LAS unsigned char* lds) {
    const Params p = load_params();
    const int tid = tid_fresh(), G = gridDim.x;
    const size_t gtid = (size_t)blockIdx.x * 512 + tid, gsz = (size_t)G * 512;
    {
        const f32x4* src = (const f32x4*)p.x; u32x2* dst = (u32x2*)(p.ws + OFF_XB);
        const size_t n4 = (size_t)MTOK * DM / 4;
        for (size_t i = gtid; i < n4; i += gsz) { const f32x4 v = src[i]; u32x2 w; w.x = cvt_pk_bf16(v[0], v[1]); w.y = cvt_pk_bf16(v[2], v[3]); dst[i] = w; }
    }
    {
        float* rope = (float*)(p.ws + OFF_ROPE);
        for (size_t i = gtid; i < (size_t)SEQ * 32; i += gsz) { const int t = (int)(i >> 5), j = (int)(i & 31);
            const float inv = (float)exp(-(double)j * (9.210340371976184 / 32.0)); const float ang = (float)t * inv;
            double s, c; sincos((double)ang, &s, &c); rope[i * 2] = (float)c; rope[i * 2 + 1] = (float)s; }
    }
    LAS float* tile = (LAS float*)lds;
    int base = 0;
    for (int j = 0; j < 17; ++j) {
        const float* src = nullptr; bf16_t* dst = nullptr; int ld = 0, K = 0, N = 0, Np = 0, ntiles;
        if (j < 2) { src = p.hyb_w_in + (size_t)j * 1024 * 2824; ld = 2824; K = 1024; N = 2824; Np = 3072; dst = (bf16_t*)(p.ws + WB_HIN) + (size_t)j * 3072 * 1024; }
        else if (j < 4) { const int l = j - 2; src = p.hyb_w_out + (size_t)l * 1024 * 1024; ld = 1024; K = 1024; N = 1024; Np = 1024; dst = (bf16_t*)(p.ws + WB_HOUT) + (size_t)l * 1024 * 1024; }
        else if (j < 6) { const int l = j - 4; src = p.rec_w_in + (size_t)l * 1024 * 2048; ld = 2048; K = 1024; N = 2048; Np = 2048; dst = (bf16_t*)(p.ws + WB_RIN) + (size_t)l * 2048 * 1024; }
        else if (j < 8) { const int l = j - 6; src = p.rec_w_out + (size_t)l * 1024 * 1024; ld = 1024; K = 1024; N = 1024; Np = 1024; dst = (bf16_t*)(p.ws + WB_ROUT) + (size_t)l * 1024 * 1024; }
        else if (j < 12) { const int l = j - 8; src = p.mlp_w1 + (size_t)l * 1024 * 4096; ld = 4096; K = 1024; N = 4096; Np = 4096; dst = (bf16_t*)(p.ws + WB_W1) + (size_t)l * 4096 * 1024; }
        else if (j < 16) { const int l = j - 12; src = p.mlp_w2 + (size_t)l * 4096 * 1024; ld = 1024; K = 4096; N = 1024; Np = 1024; dst = (bf16_t*)(p.ws + WB_W2) + (size_t)l * 1024 * 4096; }
        ntiles = (j < 16) ? (K / 64) * (Np / 64) : 256;
        for (int t = ((int)blockIdx.x - base % G + G) % G; t < ntiles; t += G) {
            if (j < 16) { const int kt = t % (K / 64), ntl = t / (K / 64); transpose_tile(src, ld, K, N, dst, kt * 64, ntl * 64, tile, tid); }
            else {
                const int idx = t >> 3, sub = t & 7, kt = sub & 3, ntl = sub >> 2, l = idx >> 4, pn = (idx >> 1) & 7, gg = idx & 1, h = pn >> 1, hh = pn & 1;
                const float* s2 = (gg ? p.rec_w_x : p.rec_w_a) + (size_t)l * 4 * 65536 + (size_t)h * 65536 + hh * 128;
                bf16_t* d2 = (bf16_t*)(p.ws + WB_RG) + (size_t)l * 2048 * 256 + (size_t)(pn * 256 + gg * 128) * 256;
                transpose_tile(s2, 256, 256, 128, d2, kt * 64, ntl * 64, tile, tid);
            }
        }
        base += ntiles;
    }
}

__device__ __forceinline__ void ln_phase(const bf16_t* Y, const float* __restrict__ g, const float* __restrict__ b, bf16_t* xb, float* outf) {
    const int tid = tid_fresh(); const int wave = tid >> 6, lane = tid & 63;
    f32x4 gv[4], bv[4];
#pragma unroll
    for (int j = 0; j < 2; ++j) { gv[2 * j] = *(const f32x4*)(g + j * 512 + lane * 8); gv[2 * j + 1] = *(const f32x4*)(g + j * 512 + lane * 8 + 4);
        bv[2 * j] = *(const f32x4*)(b + j * 512 + lane * 8); bv[2 * j + 1] = *(const f32x4*)(b + j * 512 + lane * 8 + 4); }
    const int nw = gridDim.x * 8;
    for (int row0 = blockIdx.x * 8 + wave; row0 < MTOK; row0 += 2 * nw) {
        u32x4 raw[2][2];
#pragma unroll
        for (int r = 0; r < 2; ++r) { const bf16_t* yr = Y + (size_t)(row0 + r * nw) * DM;
#pragma unroll
            for (int j = 0; j < 2; ++j) raw[r][j] = *(const u32x4*)(yr + j * 512 + lane * 8); }
#pragma unroll
        for (int r = 0; r < 2; ++r) {
            const int row = row0 + r * nw;
            f32x4 v[4];
#pragma unroll
            for (int j = 0; j < 2; ++j) { const u32x4 q = raw[r][j]; v[2 * j] = (f32x4){bflo(q.x), bfhi(q.x), bflo(q.y), bfhi(q.y)}; v[2 * j + 1] = (f32x4){bflo(q.z), bfhi(q.z), bflo(q.w), bfhi(q.w)}; }
            float s = 0.f;
#pragma unroll
            for (int j = 0; j < 4; ++j) s += (v[j][0] + v[j][1]) + (v[j][2] + v[j][3]);
            s = wave64_sum(s);
            const float mean = s * (1.0f / 1024.0f);
            float q = 0.f;
#pragma unroll
            for (int j = 0; j < 4; ++j) { const f32x4 d = v[j] - mean; q += (d[0] * d[0] + d[1] * d[1]) + (d[2] * d[2] + d[3] * d[3]); }
            q = wave64_sum(q);
            const float rstd = rsqrtf(q * (1.0f / 1024.0f) + 1e-5f);
            f32x4 o[4];
#pragma unroll
            for (int j = 0; j < 4; ++j) o[j] = (v[j] - mean) * rstd * gv[j] + bv[j];
#pragma unroll
            for (int j = 0; j < 2; ++j) {
                if (outf) { float* op = outf + (size_t)row * DM + j * 512 + lane * 8; *(f32x4*)op = o[2 * j]; *(f32x4*)(op + 4) = o[2 * j + 1]; }
                else { u32x4 w; w.x = cvt_pk_bf16(o[2 * j][0], o[2 * j][1]); w.y = cvt_pk_bf16(o[2 * j][2], o[2 * j][3]); w.z = cvt_pk_bf16(o[2 * j + 1][0], o[2 * j + 1][1]); w.w = cvt_pk_bf16(o[2 * j + 1][2], o[2 * j + 1][3]);
                    *(u32x4*)(xb + (size_t)row * DM + j * 512 + lane * 8) = w; } }
        }
    }
}

__device__ __forceinline__ void rconv_phase(const bf16_t* proj2, const float* __restrict__ cw, const float* __restrict__ cb, bf16_t* xrc) {
    const int tid = tid_fresh();
    for (int it = blockIdx.x * 512 + tid; it < 131072; it += gridDim.x * 512) {
        const int cgp = it & 127, seg = (it >> 7) & 127, b = it >> 14, c0 = cgp * 8, t0 = seg * 32;
        float w[4][8], bias[8], xw[3][8];
#pragma unroll
        for (int j = 0; j < 4; ++j) { const f32x4 a = *(const f32x4*)(cw + j * 1024 + c0), c = *(const f32x4*)(cw + j * 1024 + c0 + 4);
#pragma unroll
            for (int d = 0; d < 4; ++d) { w[j][d] = a[d]; w[j][4 + d] = c[d]; } }
        { const f32x4 a = *(const f32x4*)(cb + c0), c = *(const f32x4*)(cb + c0 + 4);
#pragma unroll
          for (int d = 0; d < 4; ++d) { bias[d] = a[d]; bias[4 + d] = c[d]; } }
#pragma unroll
        for (int j = 0; j < 3; ++j) { const int t = t0 - 3 + j;
            u32x4 v = (u32x4){0u, 0u, 0u, 0u};
            if (t >= 0) v = *(const u32x4*)(proj2 + (size_t)(b * SEQ + t) * 2048 + c0);
            xw[j][0] = bflo(v.x); xw[j][1] = bfhi(v.x); xw[j][2] = bflo(v.y); xw[j][3] = bfhi(v.y); xw[j][4] = bflo(v.z); xw[j][5] = bfhi(v.z); xw[j][6] = bflo(v.w); xw[j][7] = bfhi(v.w); }
#pragma unroll 4
        for (int t = 0; t < 32; ++t) {
            const u32x4 v = *(const u32x4*)(proj2 + (size_t)(b * SEQ + t0 + t) * 2048 + c0);
            const float x3[8] = {bflo(v.x), bfhi(v.x), bflo(v.y), bfhi(v.y), bflo(v.z), bfhi(v.z), bflo(v.w), bfhi(v.w)};
            float y[8];
#pragma unroll
            for (int d = 0; d < 8; ++d) { y[d] = bias[d] + w[0][d] * xw[0][d] + w[1][d] * xw[1][d] + w[2][d] * xw[2][d] + w[3][d] * x3[d]; xw[0][d] = xw[1][d]; xw[1][d] = xw[2][d]; xw[2][d] = x3[d]; }
            u32x4 o; o.x = cvt_pk_bf16(y[0], y[1]); o.y = cvt_pk_bf16(y[2], y[3]); o.z = cvt_pk_bf16(y[4], y[5]); o.w = cvt_pk_bf16(y[6], y[7]);
            *(u32x4*)(xrc + (size_t)(b * SEQ + t0 + t) * DM + c0) = o;
        }
    }
}
__device__ __forceinline__ void lru_ab(float ra, float ix, float x, float sp, float& a, float& b, float& l) {
    const float r = sigmoidf_(ra), ig = sigmoidf_(ix); l = r * sp; const float x2 = 2.0f * l;
    a = __expf(l);
    const float om = (x2 > -0.25f) ? -x2 * (1.0f + x2 * (0.5f + x2 * (0.16666667f + x2 * (0.041666668f + x2 * (0.0083333333f + x2 * 0.0013888889f))))) : 1.0f - a * a;
    b = sqrtf(fmaxf(om, 0.f)) * (ig * x);
}
__device__ __forceinline__ float softplus_neg8(float lm) { const float e = __expf(-lm); const float l1 = (e < 0.03f) ? e * (1.0f - e * (0.5f - e * (0.33333333f - 0.25f * e))) : __logf(1.0f + e); return -8.0f * l1; }
__device__ __forceinline__ float gelu_tanh(float x) { const float u = 0.7978845608028654f * (x + 0.044715f * x * x * x); const float t = 1.0f - 2.0f / (1.0f + __expf(2.0f * u)); return 0.5f * x * (1.0f + t); }
template <int PASS>
__device__ __forceinline__ void rscan_phase(const bf16_t* GB, const bf16_t* xrc, const float* __restrict__ b_a, const float* __restrict__ b_x, const float* __restrict__ lam, float* CLA, float* CH, bf16_t* proj2, unsigned* LB) {
    const int tid = tid_fresh();
    for (int it = blockIdx.x * 512 + tid; it < 8 * 64 * 512; it += gridDim.x * 512) {
        const int cp = it & 511, seg = (it >> 9) & 63, b = it >> 15, c = 2 * cp, gcol = (c >> 7) * 256 + (c & 127);
        float h0 = 0.f, h1 = 0.f, sl0 = 0.f, sl1 = 0.f;
        const size_t row0 = (size_t)(b * SEQ + seg * 64);
        if (PASS == 1) {
            const float ba0 = b_a[c], ba1 = b_a[c + 1], bx0 = b_x[c], bx1 = b_x[c + 1], sp0 = softplus_neg8(lam[c]), sp1 = softplus_neg8(lam[c + 1]);
            for (int t0 = 0; t0 < 64; t0 += 8) {
                unsigned ga[8], gx[8], xv[8];
#pragma unroll
                for (int t = 0; t < 8; ++t) { const size_t row = row0 + t0 + t;
                    ga[t] = *(const unsigned*)(GB + row * 2048 + gcol); gx[t] = *(const unsigned*)(GB + row * 2048 + gcol + 128); xv[t] = *(const unsigned*)(xrc + row * DM + c); }
#pragma unroll
                for (int t = 0; t < 8; ++t) { float a0, b0, a1, b1, l0, l1;
                    lru_ab(bflo(ga[t]) + ba0, bflo(gx[t]) + bx0, bflo(xv[t]), sp0, a0, b0, l0);
                    lru_ab(bfhi(ga[t]) + ba1, bfhi(gx[t]) + bx1, bfhi(xv[t]), sp1, a1, b1, l1);
                    const unsigned w0 = cvt_pk_bf16(l0, b0), w1 = cvt_pk_bf16(l1, b1);
                    *(u32x2*)(LB + (row0 + t0 + t) * DM + c) = (u32x2){w0, w1};
                    const float lr0 = bflo(w0), lr1 = bflo(w1);
                    h0 = __expf(lr0) * h0 + bfhi(w0); h1 = __expf(lr1) * h1 + bfhi(w1); sl0 += lr0; sl1 += lr1; }
            }
            const int ci = (b * 64 + seg) * 1024 + c; *(f32x2*)(CLA + ci) = (f32x2){sl0, sl1}; *(f32x2*)(CH + ci) = (f32x2){h0, h1};
        } else {
            for (int s0 = 0; s0 < seg; s0 += 8) {
                f32x2 la[8], hh[8];
#pragma unroll
                for (int k = 0; k < 8; ++k) { const int sk = (s0 + k < seg) ? s0 + k : seg - 1; const int ci = (b * 64 + sk) * 1024 + c; la[k] = *(const f32x2*)(CLA + ci); hh[k] = *(const f32x2*)(CH + ci); }
#pragma unroll
                for (int k = 0; k < 8; ++k) if (s0 + k < seg) { h0 = __expf(la[k][0]) * h0 + hh[k][0]; h1 = __expf(la[k][1]) * h1 + hh[k][1]; }
            }
            for (int t0 = 0; t0 < 64; t0 += 8) {
                u32x2 lb[8]; unsigned gt[8];
#pragma unroll
                for (int t = 0; t < 8; ++t) { const size_t row = row0 + t0 + t; lb[t] = *(const u32x2*)(LB + row * DM + c); gt[t] = *(const unsigned*)(proj2 + row * 2048 + 1024 + c); }
#pragma unroll
                for (int t = 0; t < 8; ++t) {
                    h0 = __expf(bflo(lb[t].x)) * h0 + bfhi(lb[t].x); h1 = __expf(bflo(lb[t].y)) * h1 + bfhi(lb[t].y);
                    *(unsigned*)(proj2 + (row0 + t0 + t) * 2048 + c) = cvt_pk_bf16(h0 * gelu_tanh(bflo(gt[t])), h1 * gelu_tanh(bfhi(gt[t]))); }
            }
        }
    }
}

__device__ __forceinline__ void dn_local_phase(LAS unsigned char* lds, int lj, const int n_lo, const int n_cnt, const int pb, const int npb) {
    const Params p = load_params();
    const int tid = tid_fresh(), wid = tid >> 6, lane = tid & 63, fr = lane & 15, fq = lane >> 4;
    const bf16_t* proj = (const bf16_t*)(p.ws + S_PROJ); const float* BL = (const float*)(p.ws + S_BL);
    bf16_t* QGg = (bf16_t*)(p.ws + S_QG); bf16_t* KTg = (bf16_t*)(p.ws + S_KT); bf16_t* Wg = (bf16_t*)(p.ws + S_W); bf16_t* QKg = (bf16_t*)(p.ws + S_QK);
    float* GLg = (float*)(p.ws + S_GL); float* Ug = p.out;
    const float* cw = p.hyb_conv_w + (size_t)lj * 4 * 1536;
    LAS unsigned char* Kb = lds + 16896; LAS unsigned char* Qb = lds + 34304;
    LAS float* RHS = (LAS float*)(lds + 51712); LAS float* AM = (LAS float*)lds; LAS float* Gs = (LAS float*)(lds + 16384); LAS float* Bs = (LAS float*)(lds + 16640);
    for (int idx = pb; idx < 32 * n_cnt; idx += npb) {
        const int it = (idx & 31) * 64 + n_lo + (idx >> 5);
        const int n = it & 63, h = (it >> 6) & 3, b = it >> 8;
        const int rowbase = b * SEQ + n * 64;
        if (wid == 0) {
            const float bl = BL[(size_t)(rowbase + lane) * 8 + h], al = BL[(size_t)(rowbase + lane) * 8 + 4 + h];
            const float beta = sigmoidf_(bl); const float xx = al + p.hyb_dt_bias[lj * 4 + h];
            const float sp = xx > 20.f ? xx : log1pf(__expf(xx));
            float g = -__expf(p.hyb_a_log[lj * 4 + h]) * sp;
#pragma unroll
            for (int o = 1; o < 64; o <<= 1) { const float t = __shfl_up(g, o); if (lane >= o) g += t; }
            Gs[lane] = g; Bs[lane] = beta;
            if (lane == 63) GLg[it] = g;
        }
        __syncthreads();
        {
            const int r = tid >> 3, sub = tid & 7, t = n * 64 + r;
            float y[3][16];
#pragma unroll
            for (int part = 0; part < 3; ++part) {
                const int col0 = 768 + part * 512 + h * 128 + sub * 16, c0 = part * 512 + h * 128 + sub * 16;
#pragma unroll
                for (int d = 0; d < 16; ++d) y[part][d] = 0.f;
#pragma unroll
                for (int j = 0; j < 4; ++j) { const int tt = t - 3 + j;
                    if (tt >= 0) { const bf16_t* xp = proj + (size_t)(b * SEQ + tt) * HPP + col0; const u32x4 v0 = *(const u32x4*)xp, v1 = *(const u32x4*)(xp + 8);
                        const float xs[16] = {bflo(v0.x), bfhi(v0.x), bflo(v0.y), bfhi(v0.y), bflo(v0.z), bfhi(v0.z), bflo(v0.w), bfhi(v0.w), bflo(v1.x), bfhi(v1.x), bflo(v1.y), bfhi(v1.y), bflo(v1.z), bfhi(v1.z), bflo(v1.w), bfhi(v1.w)};
                        const float* wp = cw + j * 1536 + c0;
#pragma unroll
                        for (int d4 = 0; d4 < 4; ++d4) { const f32x4 wv = *(const f32x4*)(wp + d4 * 4);
#pragma unroll
                            for (int e = 0; e < 4; ++e) y[part][d4 * 4 + e] += wv[e] * xs[d4 * 4 + e]; } } }
#pragma unroll
                for (int d = 0; d < 16; ++d) y[part][d] = y[part][d] * sigmoidf_(y[part][d]);
            }
            float sq = 0.f, sk = 0.f;
#pragma unroll
            for (int d = 0; d < 16; ++d) { sq += y[0][d] * y[0][d]; sk += y[1][d] * y[1][d]; }
            sq = row8_sum(sq); sk = row8_sum(sk);
            const float rq = rsqrtf(sq + 1e-6f) * 0.08838834764831845f, rk = rsqrtf(sk + 1e-6f);
            const float Gr = Gs[r], Gl = Gs[63], eg = __expf(Gr), et = __expf(Gl - Gr), beta = Bs[r];
            float qn[16], kn[16];
#pragma unroll
            for (int d = 0; d < 16; ++d) { qn[d] = y[0][d] * rq; kn[d] = y[1][d] * rk; }
            { u32x4 a, c;
              a.x = cvt_pk_bf16(qn[0], qn[1]); a.y = cvt_pk_bf16(qn[2], qn[3]); a.z = cvt_pk_bf16(qn[4], qn[5]); a.w = cvt_pk_bf16(qn[6], qn[7]);
              c.x = cvt_pk_bf16(qn[8], qn[9]); c.y = cvt_pk_bf16(qn[10], qn[11]); c.z = cvt_pk_bf16(qn[12], qn[13]); c.w = cvt_pk_bf16(qn[14], qn[15]);
              *(LAS u32x4*)(Qb + r * 272 + sub * 32) = a; *(LAS u32x4*)(Qb + r * 272 + sub * 32 + 16) = c;
              a.x = cvt_pk_bf16(kn[0], kn[1]); a.y = cvt_pk_bf16(kn[2], kn[3]); a.z = cvt_pk_bf16(kn[4], kn[5]); a.w = cvt_pk_bf16(kn[6], kn[7]);
              c.x = cvt_pk_bf16(kn[8], kn[9]); c.y = cvt_pk_bf16(kn[10], kn[11]); c.z = cvt_pk_bf16(kn[12], kn[13]); c.w = cvt_pk_bf16(kn[14], kn[15]);
              *(LAS u32x4*)(Kb + r * 272 + sub * 32) = a; *(LAS u32x4*)(Kb + r * 272 + sub * 32 + 16) = c;
              a.x = cvt_pk_bf16(qn[0] * eg, qn[1] * eg); a.y = cvt_pk_bf16(qn[2] * eg, qn[3] * eg); a.z = cvt_pk_bf16(qn[4] * eg, qn[5] * eg); a.w = cvt_pk_bf16(qn[6] * eg, qn[7] * eg);
              c.x = cvt_pk_bf16(qn[8] * eg, qn[9] * eg); c.y = cvt_pk_bf16(qn[10] * eg, qn[11] * eg); c.z = cvt_pk_bf16(qn[12] * eg, qn[13] * eg); c.w = cvt_pk_bf16(qn[14] * eg, qn[15] * eg);
              bf16_t* qp = QGg + (size_t)it * 8192 + r * 128 + sub * 16; *(u32x4*)qp = a; *(u32x4*)(qp + 8) = c; }
            bf16_t* ktp = KTg + (size_t)it * 8192;
#pragma unroll
            for (int d = 0; d < 16; ++d) {
                RHS[r * 256 + sub * 16 + d] = y[2][d] * beta;
                RHS[r * 256 + 128 + sub * 16 + d] = kn[d] * beta * eg;
                ktp[(sub * 16 + d) * 64 + r] = f2bf(kn[d] * et);
            }
        }
        __syncthreads();
        {
            const int ti = wid >> 1, isqk = wid & 1;
            LAS unsigned char* Xb = isqk ? Qb : Kb;
            bf16_t* qkp = QKg + (size_t)it * 4096;
#pragma unroll
            for (int tj = 0; tj < 4; ++tj) {
                if (tj <= ti) {
                    f32x4 acc = (f32x4){0.f, 0.f, 0.f, 0.f};
#pragma unroll
                    for (int ks = 0; ks < 4; ++ks) {
                        const bf16x8 a = *(LAS bf16x8*)(Xb + (ti * 16 + fr) * 272 + ks * 64 + fq * 16);
                        const bf16x8 bb = *(LAS bf16x8*)(Kb + (tj * 16 + fr) * 272 + ks * 64 + fq * 16);
                        acc = MFMA16(a, bb, acc);
                    }
                    const int j = tj * 16 + fr; const float Gj = Gs[j];
#pragma unroll
                    for (int e = 0; e < 4; ++e) { const int i = ti * 16 + 4 * fq + e; const float dec = __expf(fminf(Gs[i] - Gj, 0.f));
                        if (isqk) qkp[i * 64 + j] = (i >= j) ? f2bf(acc[e] * dec) : (bf16_t)0;
                        else AM[i * 64 + j] = (i > j) ? Bs[i] * acc[e] * dec : 0.f; }
                } else if (isqk) {
                    const int j = tj * 16 + fr;
#pragma unroll
                    for (int e = 0; e < 4; ++e) qkp[(ti * 16 + 4 * fq + e) * 64 + j] = (bf16_t)0;
                }
            }
        }
        __syncthreads();
        if (tid < 256) {
            const int c = tid;
            LAS float* RHSc = RHS + c;
            float X[64];
#pragma unroll
            for (int i = 0; i < 64; ++i) {
                float a0 = RHSc[i * 256], a1 = 0.f, a2 = 0.f, a3 = 0.f;
#pragma unroll
                for (int j4 = 0; j4 < (i + 3) / 4; ++j4) {
                    const f32x4 av = *(LAS f32x4*)(AM + i * 64 + j4 * 4);
                    if (j4 * 4 + 0 < i) a0 -= av[0] * X[j4 * 4 + 0];
                    if (j4 * 4 + 1 < i) a1 -= av[1] * X[j4 * 4 + 1];
                    if (j4 * 4 + 2 < i) a2 -= av[2] * X[j4 * 4 + 2];
                    if (j4 * 4 + 3 < i) a3 -= av[3] * X[j4 * 4 + 3];
                }
                X[i] = (a0 + a1) + (a2 + a3);
            }
            if (c < 128) {
                float* up = Ug + (size_t)it * 8192; const int slice = c >> 4, nn = c & 15;
#pragma unroll
                for (int mt = 0; mt < 4; ++mt)
#pragma unroll
                    for (int qq = 0; qq < 4; ++qq) { const int i0 = mt * 16 + qq * 4;
                        *(f32x4*)(up + ((slice * 4 + mt) * 64 + qq * 16 + nn) * 4) = (f32x4){X[i0], X[i0 + 1], X[i0 + 2], X[i0 + 3]}; }
            } else {
                bf16_t* wp = Wg + (size_t)it * 8192 + (c - 128);
#pragma unroll
                for (int i = 0; i < 64; ++i) wp[i * 128] = f2bf(X[i]);
            }
        }
        __syncthreads();
    }
}

__device__ __forceinline__ void dn_scan_chain(LAS unsigned char* lds, int lj, int chain, unsigned* half_cnt, const unsigned half_need) {
    const Params p = load_params();
    const int tid = tid_fresh(), w = __builtin_amdgcn_readfirstlane(tid >> 6), lane = tid & 63, fr = lane & 15, fq = lane >> 4;
    const int b = chain >> 2, h = chain & 3;
    const bf16_t* QGg = (const bf16_t*)(p.ws + S_QG); const bf16_t* KTg = (const bf16_t*)(p.ws + S_KT); const bf16_t* Wg = (const bf16_t*)(p.ws + S_W); const bf16_t* QKg = (const bf16_t*)(p.ws + S_QK);
    const float* GLg = (const float*)(p.ws + S_GL); const float* Ug = p.out;
    bf16_t* ORAW = (bf16_t*)(p.out + (size_t)16 * 1024 * 1024);
    f32x4 S[8];
#pragma unroll
    for (int i = 0; i < 8; ++i) S[i] = (f32x4){0.f, 0.f, 0.f, 0.f};
    u32x4 st[7]; f32x4 unext[4];
#define DN_WRITE(bufb) do { LAS unsigned char* _b = lds + (bufb); \
        _Pragma("unroll") for (int i = 0; i < 2; ++i) { const int q = tid + 512 * i; \
            *(LAS u32x4*)(_b + (q >> 4) * 272 + (q & 15) * 16) = st[i]; \
            *(LAS u32x4*)(_b + 17408 + (q >> 4) * 272 + (q & 15) * 16) = st[2 + i]; \
            *(LAS u32x4*)(_b + 34816 + (q >> 3) * 144 + (q & 7) * 16) = st[4 + i]; } \
        *(LAS u32x4*)(_b + 53248 + (tid >> 3) * 144 + (tid & 7) * 16) = st[6]; } while (0)
#define DN_ISSUE_ST(it_) do { const size_t _it = (size_t)(it_); \
        const u32x4* gW = (const u32x4*)(Wg + _it * 8192); const u32x4* gQ = (const u32x4*)(QGg + _it * 8192); const u32x4* gK = (const u32x4*)(KTg + _it * 8192); const u32x4* gP = (const u32x4*)(QKg + _it * 4096); \
        st[0] = gW[tid]; st[1] = gW[tid + 512]; st[2] = gQ[tid]; st[3] = gQ[tid + 512]; st[4] = gK[tid]; st[5] = gK[tid + 512]; st[6] = gP[tid]; } while (0)
#define DN_ISSUE_U(it_) do { const size_t _it = (size_t)(it_); \
        _Pragma("unroll") for (int mt = 0; mt < 4; ++mt) unext[mt] = *(const f32x4*)(Ug + _it * 8192 + ((w * 4 + mt) * 64 + lane) * 4); } while (0)
    DN_ISSUE_ST(chain * 64);
    DN_ISSUE_U(chain * 64);
    float gln = GLg[chain * 64];
    DN_WRITE(0);
    DN_ISSUE_ST(chain * 64 + 1);
    __syncthreads();
    for (int n = 0; n < 64; ++n) {
        const int it = chain * 64 + n;
        f32x4 ucur[4];
#pragma unroll
        for (int mt = 0; mt < 4; ++mt) ucur[mt] = unext[mt];
        const float eg = __expf(gln);
        if (n == 22 || n == 42) {
            if (tid == 0) { unsigned* hc = half_cnt + (n == 22 ? 0 : 32); XB_SPIN(xb_ld(hc) < half_need, (unsigned*)(p.ws + OFF_BAR)); }
            __syncthreads();
            __builtin_amdgcn_fence(__ATOMIC_ACQUIRE, "agent"); asm volatile("s_waitcnt vmcnt(0)" ::: "memory");
        }
        const int itn = n < 63 ? it + 1 : it, itn2 = n < 62 ? it + 2 : it;
        DN_ISSUE_U(itn);
        gln = GLg[itn];
        const int rowb = b * SEQ + n * 64;
        if (n > 0) {
            LAS unsigned char* ob = lds + 124928 + ((n - 1) & 1) * 16384;
#pragma unroll
            for (int i = 0; i < 2; ++i) { const int q = tid + 512 * i, row = q >> 4, cc = q & 15;
                *(u32x4*)(ORAW + (size_t)(rowb - 64 + row) * 512 + h * 128 + cc * 8) = *(LAS u32x4*)(ob + row * 256 + cc * 16); }
        }
        LAS unsigned char* bb = lds + (n & 1) * 62464;
        bf16x8 Sb[4];
#pragma unroll
        for (int ks = 0; ks < 4; ++ks) Sb[ks] = pack8(S[2 * ks], S[2 * ks + 1]);
        f32x4 vn[4], oa[4];
#pragma unroll
        for (int mt = 0; mt < 4; ++mt) {
            bf16x8 Aw[4], Aq[4];
#pragma unroll
            for (int ks = 0; ks < 4; ++ks) { Aw[ks] = ldA_split(bb, 16 * mt + fr, 32 * ks + 4 * fq, 272); Aq[ks] = ldA_split(bb + 17408, 16 * mt + fr, 32 * ks + 4 * fq, 272); }
            __builtin_amdgcn_sched_barrier(0);
            f32x4 a1 = (f32x4){0.f, 0.f, 0.f, 0.f}, a2 = (f32x4){0.f, 0.f, 0.f, 0.f};
#pragma unroll
            for (int ks = 0; ks < 4; ++ks) { a1 = MFMA16(Aw[ks], Sb[ks], a1); a2 = MFMA16(Aq[ks], Sb[ks], a2); }
            vn[mt] = ucur[mt] - a1; oa[mt] = a2;
            __builtin_amdgcn_sched_barrier(0);
        }
        bf16x8 Vb[2];
        Vb[0] = pack8(vn[0], vn[1]); Vb[1] = pack8(vn[2], vn[3]);
#pragma unroll
        for (int hf = 0; hf < 2; ++hf) {
            bf16x8 Ak[4][2];
#pragma unroll
            for (int d = 0; d < 4; ++d)
#pragma unroll
                for (int k2 = 0; k2 < 2; ++k2) Ak[d][k2] = ldA_split(bb + 34816, 16 * (4 * hf + d) + fr, 32 * k2 + 4 * fq, 144);
            __builtin_amdgcn_sched_barrier(0);
#pragma unroll
            for (int d = 0; d < 4; ++d) { const int dt = 4 * hf + d; S[dt] = S[dt] * eg;
#pragma unroll
                for (int k2 = 0; k2 < 2; ++k2) S[dt] = MFMA16(Ak[d][k2], Vb[k2], S[dt]); }
            __builtin_amdgcn_sched_barrier(0);
        }
        {
            bf16x8 Ap[4][2];
#pragma unroll
            for (int mt = 0; mt < 4; ++mt)
#pragma unroll
                for (int k2 = 0; k2 < 2; ++k2) Ap[mt][k2] = ldA_split(bb + 53248, 16 * mt + fr, 32 * k2 + 4 * fq, 144);
            __builtin_amdgcn_sched_barrier(0);
#pragma unroll
            for (int mt = 0; mt < 4; ++mt)
#pragma unroll
                for (int k2 = 0; k2 < 2; ++k2) oa[mt] = MFMA16(Ap[mt][k2], Vb[k2], oa[mt]);
        }
        { LAS unsigned char* ob = lds + 124928 + (n & 1) * 16384 + (16 * w + fr) * 2;
#pragma unroll
          for (int mt = 0; mt < 4; ++mt)
#pragma unroll
              for (int e = 0; e < 4; ++e) *(LAS bf16_t*)(ob + (16 * mt + 4 * fq + e) * 256) = f2bf(oa[mt][e]); }
        DN_WRITE(((n + 1) & 1) * 62464);
        DN_ISSUE_ST(itn2);
        __syncthreads();
    }
    {
        const int rowl = b * SEQ + 63 * 64; LAS unsigned char* ob = lds + 124928 + 16384;
#pragma unroll
        for (int i = 0; i < 2; ++i) { const int q = tid + 512 * i, row = q >> 4, cc = q & 15;
            *(u32x4*)(ORAW + (size_t)(rowl + row) * 512 + h * 128 + cc * 8) = *(LAS u32x4*)(ob + row * 256 + cc * 16); }
    }
#undef DN_ISSUE_ST
#undef DN_ISSUE_U
#undef DN_WRITE
}

__device__ __forceinline__ void dn_gate_phase(int lj) {
    const Params p = load_params();
    const int tid = tid_fresh();
    bf16_t* proj = (bf16_t*)(p.ws + S_PROJ); const bf16_t* ORAW = (const bf16_t*)(p.out + (size_t)16 * 1024 * 1024);
    const int sub = tid & 15;
    const f32x4 nw0 = *(const f32x4*)(p.hyb_norm_w + lj * 128 + sub * 8), nw1 = *(const f32x4*)(p.hyb_norm_w + lj * 128 + sub * 8 + 4);
    const float nwv[8] = {nw0[0], nw0[1], nw0[2], nw0[3], nw1[0], nw1[1], nw1[2], nw1[3]};
    for (int pr = (blockIdx.x * 512 + tid) >> 4; pr < MTOK * 4; pr += (gridDim.x * 512) >> 4) {
        const int row = pr >> 2, hh = pr & 3;
        const u32x4 ov = *(const u32x4*)(ORAW + (size_t)row * 512 + hh * 128 + sub * 8);
        bf16_t* zp = proj + (size_t)row * HPP + 2304 + hh * 128 + sub * 8;
        const u32x4 zv = *(const u32x4*)zp;
        const float o[8] = {bflo(ov.x), bfhi(ov.x), bflo(ov.y), bfhi(ov.y), bflo(ov.z), bfhi(ov.z), bflo(ov.w), bfhi(ov.w)};
        const float z[8] = {bflo(zv.x), bfhi(zv.x), bflo(zv.y), bfhi(zv.y), bflo(zv.z), bfhi(zv.z), bflo(zv.w), bfhi(zv.w)};
        float ss = 0.f;
#pragma unroll
        for (int d = 0; d < 8; ++d) ss += o[d] * o[d];
        ss = row16_sum(ss);
        const float rstd = rsqrtf(ss * (1.0f / 128.0f) + 1e-6f);
        float r[8];
#pragma unroll
        for (int d = 0; d < 8; ++d) r[d] = o[d] * rstd * nwv[d] * (z[d] * sigmoidf_(z[d]));
        u32x4 w; w.x = cvt_pk_bf16(r[0], r[1]); w.y = cvt_pk_bf16(r[2], r[3]); w.z = cvt_pk_bf16(r[4], r[5]); w.w = cvt_pk_bf16(r[6], r[7]);
        *(u32x4*)zp = w;
    }
}

__device__ __forceinline__ void attn_items(LAS unsigned char* lds, int lj, int ab, int nab) {
    const Params p = load_params();
    const int tid = tid_fresh(), w = __builtin_amdgcn_readfirstlane(tid >> 6), lane = tid & 63, fr = lane & 15, fq = lane >> 4;
    bf16_t* proj = (bf16_t*)(p.ws + S_PROJ); const float* rope = (const float*)(p.ws + OFF_ROPE);
    LAS unsigned char* KS = lds; LAS unsigned char* VT = lds + 36864;
    for (int item = ab; item < 512; item += nab) {
        const int kvh = item & 1, nb = (item >> 1) & 31, b = item >> 6;
        {
            const int kb = tid >> 1, hf = tid & 1, pos = (nb - 1) * 128 + kb;
            u32x4 o1a = (u32x4){0u, 0u, 0u, 0u}, o1b = o1a, o2a = o1a, o2b = o1a;
            if (pos >= 0) {
                const bf16_t* kp = proj + (size_t)(b * SEQ + pos) * HPP + 512 + kvh * 64 + 16 * hf;
                const u32x4 x1a = *(const u32x4*)kp, x1b = *(const u32x4*)(kp + 8), x2a = *(const u32x4*)(kp + 32), x2b = *(const u32x4*)(kp + 40);
                const float x1[16] = {bflo(x1a.x), bfhi(x1a.x), bflo(x1a.y), bfhi(x1a.y), bflo(x1a.z), bfhi(x1a.z), bflo(x1a.w), bfhi(x1a.w), bflo(x1b.x), bfhi(x1b.x), bflo(x1b.y), bfhi(x1b.y), bflo(x1b.z), bfhi(x1b.z), bflo(x1b.w), bfhi(x1b.w)};
                const float x2[16] = {bflo(x2a.x), bfhi(x2a.x), bflo(x2a.y), bfhi(x2a.y), bflo(x2a.z), bfhi(x2a.z), bflo(x2a.w), bfhi(x2a.w), bflo(x2b.x), bfhi(x2b.x), bflo(x2b.y), bfhi(x2b.y), bflo(x2b.z), bfhi(x2b.z), bflo(x2b.w), bfhi(x2b.w)};
                const float* rp = rope + ((size_t)pos * 32 + 16 * hf) * 2;
                float r1[16], r2[16];
#pragma unroll
                for (int d2 = 0; d2 < 8; ++d2) { const f32x4 cs = *(const f32x4*)(rp + d2 * 4);
                    r1[2 * d2] = x1[2 * d2] * cs[0] - x2[2 * d2] * cs[1]; r2[2 * d2] = x2[2 * d2] * cs[0] + x1[2 * d2] * cs[1];
                    r1[2 * d2 + 1] = x1[2 * d2 + 1] * cs[2] - x2[2 * d2 + 1] * cs[3]; r2[2 * d2 + 1] = x2[2 * d2 + 1] * cs[2] + x1[2 * d2 + 1] * cs[3]; }
                o1a.x = cvt_pk_bf16(r1[0], r1[1]); o1a.y = cvt_pk_bf16(r1[2], r1[3]); o1a.z = cvt_pk_bf16(r1[4], r1[5]); o1a.w = cvt_pk_bf16(r1[6], r1[7]);
                o1b.x = cvt_pk_bf16(r1[8], r1[9]); o1b.y = cvt_pk_bf16(r1[10], r1[11]); o1b.z = cvt_pk_bf16(r1[12], r1[13]); o1b.w = cvt_pk_bf16(r1[14], r1[15]);
                o2a.x = cvt_pk_bf16(r2[0], r2[1]); o2a.y = cvt_pk_bf16(r2[2], r2[3]); o2a.z = cvt_pk_bf16(r2[4], r2[5]); o2a.w = cvt_pk_bf16(r2[6], r2[7]);
                o2b.x = cvt_pk_bf16(r2[8], r2[9]); o2b.y = cvt_pk_bf16(r2[10], r2[11]); o2b.z = cvt_pk_bf16(r2[12], r2[13]); o2b.w = cvt_pk_bf16(r2[14], r2[15]);
            }
            LAS unsigned char* kd = KS + kb * 144 + hf * 32;
            *(LAS u32x4*)kd = o1a; *(LAS u32x4*)(kd + 16) = o1b; *(LAS u32x4*)(kd + 64) = o2a; *(LAS u32x4*)(kd + 80) = o2b;
        }
        {
#pragma unroll
            for (int i = 0; i < 4; ++i) { const int q = tid + 512 * i, key = q >> 3, dc = q & 7, pos = (nb - 1) * 128 + key;
                u32x4 v = (u32x4){0u, 0u, 0u, 0u};
                if (pos >= 0) v = *(const u32x4*)(proj + (size_t)(b * SEQ + pos) * HPP + 640 + kvh * 64 + 8 * dc);
                LAS bf16_t* vd = (LAS bf16_t*)VT + (8 * dc) * 280 + key;
                vd[0] = (bf16_t)(v.x & 0xffffu); vd[280] = (bf16_t)(v.x >> 16); vd[2 * 280] = (bf16_t)(v.y & 0xffffu); vd[3 * 280] = (bf16_t)(v.y >> 16);
                vd[4 * 280] = (bf16_t)(v.z & 0xffffu); vd[5 * 280] = (bf16_t)(v.z >> 16); vd[6 * 280] = (bf16_t)(v.w & 0xffffu); vd[7 * 280] = (bf16_t)(v.w >> 16); }
            if (tid < 128) *(LAS u32x4*)(VT + (tid >> 1) * 560 + 512 + (tid & 1) * 16) = (u32x4){0u, 0u, 0u, 0u};
        }
        __syncthreads();
        const int qi = 16 * w + fr, pos_q = nb * 128 + qi, rowq = b * SEQ + pos_q;
        const int dl = fr - 4 * fq;
#pragma unroll 1
        for (int g = 0; g < 4; ++g) {
            const int head = kvh * 4 + g;
            bf16x8 Qf[2];
            { const bf16_t* qp = proj + (size_t)rowq * HPP + head * 64 + 8 * fq;
              const u32x4 xa = *(const u32x4*)qp, xb = *(const u32x4*)(qp + 32);
              const float x1[8] = {bflo(xa.x), bfhi(xa.x), bflo(xa.y), bfhi(xa.y), bflo(xa.z), bfhi(xa.z), bflo(xa.w), bfhi(xa.w)};
              const float x2[8] = {bflo(xb.x), bfhi(xb.x), bflo(xb.y), bfhi(xb.y), bflo(xb.z), bfhi(xb.z), bflo(xb.w), bfhi(xb.w)};
              const float* rp = rope + ((size_t)pos_q * 32 + 8 * fq) * 2;
              float r1[8], r2[8];
#pragma unroll
              for (int d2 = 0; d2 < 4; ++d2) { const f32x4 cs = *(const f32x4*)(rp + d2 * 4);
                  r1[2 * d2] = (x1[2 * d2] * cs[0] - x2[2 * d2] * cs[1]) * 0.125f; r2[2 * d2] = (x2[2 * d2] * cs[0] + x1[2 * d2] * cs[1]) * 0.125f;
                  r1[2 * d2 + 1] = (x1[2 * d2 + 1] * cs[2] - x2[2 * d2 + 1] * cs[3]) * 0.125f; r2[2 * d2 + 1] = (x2[2 * d2 + 1] * cs[2] + x1[2 * d2 + 1] * cs[3]) * 0.125f; }
              u32x4 a, c; a.x = cvt_pk_bf16(r1[0], r1[1]); a.y = cvt_pk_bf16(r1[2], r1[3]); a.z = cvt_pk_bf16(r1[4], r1[5]); a.w = cvt_pk_bf16(r1[6], r1[7]);
              c.x = cvt_pk_bf16(r2[0], r2[1]); c.y = cvt_pk_bf16(r2[2], r2[3]); c.z = cvt_pk_bf16(r2[4], r2[5]); c.w = cvt_pk_bf16(r2[6], r2[7]);
              Qf[0] = __builtin_bit_cast(bf16x8, a); Qf[1] = __builtin_bit_cast(bf16x8, c); }
            const float sink = p.hyb_sinks[lj * 8 + head];
            f32x4 sc[9];
            float mx = sink;
#pragma unroll
            for (int tt = 0; tt < 9; ++tt) {
                const int kt = w + tt;
                const bf16x8 k0 = *(LAS bf16x8*)(KS + (16 * kt + fr) * 144 + fq * 16), k1 = *(LAS bf16x8*)(KS + (16 * kt + fr) * 144 + 64 + fq * 16);
                f32x4 a = (f32x4){0.f, 0.f, 0.f, 0.f};
                a = MFMA16(k0, Qf[0], a); a = MFMA16(k1, Qf[1], a);
                const bool dead = (nb == 0) && (kt < 8);
#pragma unroll
                for (int e = 0; e < 4; ++e) { bool valid = !dead;
                    if (tt == 0) valid = valid && (e > dl);
                    if (tt == 8) valid = valid && (e <= dl);
                    a[e] = valid ? a[e] : -INFINITY; mx = fmaxf(mx, a[e]); }
                sc[tt] = a;
            }
            mx = fmaxf(mx, __shfl_xor(mx, 16)); mx = fmaxf(mx, __shfl_xor(mx, 32));
            float l = 0.f;
#pragma unroll
            for (int tt = 0; tt < 9; ++tt)
#pragma unroll
                for (int e = 0; e < 4; ++e) { const float pv = __expf(sc[tt][e] - mx); sc[tt][e] = pv; l += pv; }
            l += __shfl_xor(l, 16); l += __shfl_xor(l, 32);
            l += __expf(sink - mx);
            const float inv = 1.0f / l;
            f32x4 oacc[4];
#pragma unroll
            for (int mt = 0; mt < 4; ++mt) oacc[mt] = (f32x4){0.f, 0.f, 0.f, 0.f};
#pragma unroll
            for (int kk = 0; kk < 5; ++kk) {
                const bf16x8 Pb = pack8(sc[2 * kk], kk < 4 ? sc[2 * kk + 1] : (f32x4){0.f, 0.f, 0.f, 0.f});
                const int key0 = 16 * (w + 2 * kk) + 4 * fq;
#pragma unroll
                for (int mt = 0; mt < 4; ++mt) oacc[mt] = MFMA16(ldA_split(VT, 16 * mt + fr, key0, 560), Pb, oacc[mt]);
            }
            bf16_t* op = proj + (size_t)rowq * HPP + 1792 + head * 64 + 4 * fq;
#pragma unroll
            for (int mt = 0; mt < 4; ++mt) { u32x2 o; o.x = cvt_pk_bf16(oacc[mt][0] * inv, oacc[mt][1] * inv); o.y = cvt_pk_bf16(oacc[mt][2] * inv, oacc[mt][3] * inv); *(u32x2*)(op + 16 * mt) = o; }
        }
        __syncthreads();
    }
}

#define GSYNC() do { TSM(ph_cls); xcd_barrier((unsigned*)(load_params().ws + OFF_BAR), xb_x, (volatile LAS unsigned*)(lds + LDS_CTL + 128)); TSM(2); } while (0)
template <int layer>
__device__ __forceinline__ void layer_body(LAS unsigned char* lds, const unsigned xb_x, const int G, const int bid) {
    int ph_cls = 0; (void)ph_cls;
        const int lj = layer >> 1;
        if ((layer & 1) == 0) {
            {
                const Params p = load_params();
                pg8::Gemm g{(const bf16_t*)(p.ws + OFF_XB), (const bf16_t*)(p.ws + WB_HIN) + (size_t)lj * 3072 * 1024, MTOK, 3072, 1024, 1024};
                pg8::Order S; S.init(MTOK, 3072, G, bid, 0);
                pg8::EpiProjHyb E{(bf16_t*)(p.ws + S_PROJ), (float*)(p.ws + S_BL)};
                PHC(1); pg8::gemm_phase(lds, g, S, E);
            }
            GSYNC();
            PHC(3); dn_local_phase(lds, lj, 0, 24, bid, G);
            GSYNC();
            PHC(7);
            {
                unsigned* half_cnt = (unsigned*)(load_params().ws + OFF_BAR) + 4096 + 64 * lj;
                if (bid < 32) dn_scan_chain(lds, lj, bid, half_cnt, (unsigned)(G - 32));
                else {
                    dn_local_phase(lds, lj, 24, 20, bid - 32, G - 32);
                    asm volatile("s_waitcnt vmcnt(0)" ::: "memory"); __syncthreads();
                    if (threadIdx.x == 0) { __builtin_amdgcn_fence(__ATOMIC_RELEASE, "agent"); asm volatile("s_waitcnt vmcnt(0)" ::: "memory"); (void)xb_add(half_cnt, 1u); }
                    dn_local_phase(lds, lj, 44, 20, bid - 32, G - 32);
                    asm volatile("s_waitcnt vmcnt(0)" ::: "memory"); __syncthreads();
                    if (threadIdx.x == 0) { __builtin_amdgcn_fence(__ATOMIC_RELEASE, "agent"); asm volatile("s_waitcnt vmcnt(0)" ::: "memory"); (void)xb_add(half_cnt + 32, 1u); }
                    attn_items(lds, lj, bid - 32, G - 32);
                }
            }
            GSYNC();
            PHC(3); dn_gate_phase(lj);
            GSYNC();
            {
                const Params p = load_params();
                pg8::Gemm g{(const bf16_t*)(p.ws + S_PROJ) + 1792, (const bf16_t*)(p.ws + WB_HOUT) + (size_t)lj * 1024 * 1024, MTOK, 1024, 1024, HPP};
                pg8::Order S; S.init(MTOK, 1024, G, bid, 0);
                pg8::EpiResid E{(const bf16_t*)(p.ws + OFF_XB), (bf16_t*)(p.ws + OFF_Y)};
                PHC(1); pg8::gemm_phase(lds, g, S, E);
            }
        } else {
            {
                const Params p = load_params();
                pg8::Gemm g{(const bf16_t*)(p.ws + OFF_XB), (const bf16_t*)(p.ws + WB_RIN) + (size_t)lj * 2048 * 1024, MTOK, 2048, 1024, 1024};
                pg8::Order S; S.init(MTOK, 2048, G, bid, 0);
                pg8::EpiBf16<0> E{(bf16_t*)(p.ws + S_PROJ2), 2048};
                PHC(1); pg8::gemm_phase(lds, g, S, E);
            }
            GSYNC();
            { const Params p = load_params();
              PHC(4); rconv_phase((const bf16_t*)(p.ws + S_PROJ2), p.rec_conv_w + (size_t)lj * 4 * 1024, p.rec_conv_b + lj * 1024, (bf16_t*)(p.ws + S_XRC)); }
            GSYNC();
            {
                const Params p = load_params();
                pg8::Gemm g{(const bf16_t*)(p.ws + S_XRC), (const bf16_t*)(p.ws + WB_RG) + (size_t)lj * 2048 * 256, MTOK, 2048, 256, 1024};
                pg8::Order S; S.init(MTOK, 2048, G, bid, 1);
                pg8::EpiBf16<0> E{(bf16_t*)(p.ws + S_LA), 2048};
                PHC(1); pg8::gemm_phase(lds, g, S, E);
            }
            GSYNC();
            { const Params p = load_params(); PHC(4); rscan_phase<1>((const bf16_t*)(p.ws + S_LA), (const bf16_t*)(p.ws + S_XRC), p.rec_b_a + lj * 1024, p.rec_b_x + lj * 1024, p.rec_lambda + lj * 1024, (float*)(p.ws + S_CLA), (float*)(p.ws + S_CH), (bf16_t*)(p.ws + S_PROJ2), (unsigned*)p.out); }
            GSYNC();
            { const Params p = load_params(); PHC(4); rscan_phase<2>((const bf16_t*)(p.ws + S_LA), (const bf16_t*)(p.ws + S_XRC), p.rec_b_a + lj * 1024, p.rec_b_x + lj * 1024, p.rec_lambda + lj * 1024, (float*)(p.ws + S_CLA), (float*)(p.ws + S_CH), (bf16_t*)(p.ws + S_PROJ2), (unsigned*)p.out); }
            GSYNC();
            {
                const Params p = load_params();
                pg8::Gemm g{(const bf16_t*)(p.ws + S_PROJ2), (const bf16_t*)(p.ws + WB_ROUT) + (size_t)lj * 1024 * 1024, MTOK, 1024, 1024, 2048};
                pg8::Order S; S.init(MTOK, 1024, G, bid, 0);
                pg8::EpiResid E{(const bf16_t*)(p.ws + OFF_XB), (bf16_t*)(p.ws + OFF_Y)};
                PHC(1); pg8::gemm_phase(lds, g, S, E);
            }
        }
        GSYNC();
        { const Params p = load_params(); PHC(5); ln_phase((const bf16_t*)(p.ws + OFF_Y), p.ln1_g + layer * 1024, p.ln1_b + layer * 1024, (bf16_t*)(p.ws + OFF_XB), nullptr); }
        GSYNC();
        {
            const Params p = load_params();
            pg8::Gemm g{(const bf16_t*)(p.ws + OFF_XB), (const bf16_t*)(p.ws + WB_W1) + (size_t)layer * 4096 * 1024, MTOK, 4096, 1024, 1024};
            pg8::Order S; S.init(MTOK, 4096, G, bid, 0);
            pg8::EpiBf16<1> E{(bf16_t*)(p.ws + S_H), 4096};
            PHC(1); pg8::gemm_phase(lds, g, S, E);
        }
        GSYNC();
        {
            const Params p = load_params();
            pg8::Gemm g{(const bf16_t*)(p.ws + S_H), (const bf16_t*)(p.ws + WB_W2) + (size_t)layer * 1024 * 4096, MTOK, 1024, 4096, 4096};
            pg8::Order S; S.init(MTOK, 1024, G, bid, 0);
            pg8::EpiResid E{(const bf16_t*)(p.ws + OFF_XB), (bf16_t*)(p.ws + OFF_Y)};
            PHC(1); pg8::gemm_phase(lds, g, S, E);
        }
        GSYNC();
        { const Params p = load_params(); PHC(5); ln_phase((const bf16_t*)(p.ws + OFF_Y), p.ln2_g + layer * 1024, p.ln2_b + layer * 1024, (bf16_t*)(p.ws + OFF_XB), layer == 3 ? p.out : nullptr); }
        if (layer < 3) GSYNC();
#ifdef TS_SELECT
        else GSYNC();
#endif
}

__global__ void __launch_bounds__(512) mega_fwd(Params p_unused) {
    extern __shared__ __attribute__((aligned(16))) unsigned char smem_raw[];
    LAS unsigned char* lds = (LAS unsigned char*)smem_raw;
    cg::grid_group grid = cg::this_grid();
    grid.sync();
    const int G = gridDim.x, bid = blockIdx.x;
    if (threadIdx.x < 2) ((LAS unsigned*)(lds + LDS_CTL + 128))[threadIdx.x] = 0u;
    __syncthreads();
    const unsigned xb_x = xb_xcc_id();
    if (threadIdx.x == 0) (void)xb_add(&((unsigned*)(load_params().ws + OFF_BAR))[XB_XCNT(xb_x)], 1u);
#ifdef TS_SELECT
    int ph_cls = 0;
    if (threadIdx.x < 64) ((LAS unsigned*)(lds + LDS_CTL))[threadIdx.x] = 0u;
    __syncthreads();
    if (blockIdx.x == TS_BLOCK && threadIdx.x == 0) { ((LAS unsigned*)(lds + LDS_CTL))[0] = (unsigned)__builtin_amdgcn_s_memrealtime(); ((LAS unsigned*)(lds + LDS_CTL))[1] = ((LAS unsigned*)(lds + LDS_CTL))[0]; }
#endif

    prep_phase(lds);
    GSYNC();

    layer_body<0>(lds, xb_x, G, bid);
    layer_body<1>(lds, xb_x, G, bid);
    layer_body<2>(lds, xb_x, G, bid);
    layer_body<3>(lds, xb_x, G, bid);
#ifdef TS_SELECT
    if (blockIdx.x == TS_BLOCK) {
        LAS unsigned* tw = (LAS unsigned*)(lds + LDS_CTL);
        unsigned ticks = (TS_SELECT == 6) ? (tw[0] - tw[1]) : tw[2 + TS_SELECT];
        const unsigned K = ticks / 50u; float* o = load_params().out;
        for (unsigned i = threadIdx.x; i < K; i += 512) o[i] += 0.09f;
    }
#endif
}

extern "C" void kernel_launch(void* const* d_in, const int* in_sizes, int n_in, void* d_out, int out_size, void* d_ws, size_t ws_size, hipStream_t stream) {
    static int grid = 0;
    if (grid == 0) {
        if (n_in != 23 || out_size != MTOK * DM || ws_size < WS_NEED) { fprintf(stderr, "kernel_launch: unexpected shapes (n_in %d, out %d, ws %zu)\n", n_in, out_size, ws_size); grid = -1; return; }
        int dev = 0, cus = 0, per_cu = 0;
        (void)hipGetDevice(&dev); (void)hipDeviceGetAttribute(&cus, hipDeviceAttributeMultiprocessorCount, dev);
        if (hipFuncSetAttribute((const void*)mega_fwd, hipFuncAttributeMaxDynamicSharedMemorySize, LDS_BYTES) != hipSuccess) { fprintf(stderr, "kernel_launch: hipFuncSetAttribute failed\n"); grid = -1; return; }
        (void)hipOccupancyMaxActiveBlocksPerMultiprocessor(&per_cu, (const void*)mega_fwd, 512, LDS_BYTES);
        if (per_cu < 1) { fprintf(stderr, "kernel_launch: occupancy query says 0\n"); per_cu = 1; }
        (void)hipGetLastError();
        grid = cus;
    }
    if (grid < 0) return;
    (void)hipMemsetAsync((char*)d_ws + OFF_BAR, 0, 32768, stream);
    Params p{};
    const float** pp = (const float**)&p;
    for (int i = 0; i < 23; ++i) pp[i] = (const float*)d_in[i];
    p.out = (float*)d_out; p.ws = (unsigned char*)d_ws;
    void* args[] = {&p};
    hipError_t e = hipLaunchCooperativeKernel((const void*)mega_fwd, dim3(grid), dim3(512), args, LDS_BYTES, stream);
    if (e != hipSuccess) fprintf(stderr, "cooperative launch failed: %s (grid %d)\n", hipGetErrorString(e), grid);
}
```
